# Optimizing an MI355X kernel written in HIP

```python
import math
import jax
import jax.numpy as jnp
from jax import lax
import numpy as np

D_MODEL = 2048
BATCH = 2
SEQ = 8192
DEPTH = 2

GRID_W = 64
CTX_LEN = 256
EPS = 1e-6

SSM_WIDTH = 512
SSM_GROUP = 16
SSM_GROUPS = SSM_WIDTH // SSM_GROUP
SSM_STATE = 64
DT_MIN = 1e-3
DT_MAX = 1e-1

ATTN_HEADS = 8
ATTN_KV_HEADS = 2
HEAD_DIM = 128
ATTN_WIDTH = ATTN_HEADS * HEAD_DIM
KV_WIDTH = ATTN_KV_HEADS * HEAD_DIM
Q_BLOCK = 128
ROPE_THETA = 10000.0

MLSTM_HEADS = 4
MLSTM_HEAD_DIM = 128
MLSTM_WIDTH = MLSTM_HEADS * MLSTM_HEAD_DIM
MLSTM_CHUNK = 128
CONV_WIDTH = 3
N_GATES = 4 * MLSTM_HEADS

SECTION_SIZES = (SSM_WIDTH, SSM_WIDTH,
                 ATTN_WIDTH, KV_WIDTH, KV_WIDTH, ATTN_WIDTH,
                 MLSTM_WIDTH, MLSTM_WIDTH, MLSTM_WIDTH, MLSTM_WIDTH, N_GATES, MLSTM_WIDTH)
IN_COLS = sum(SECTION_SIZES)
MIX_WIDTH = SSM_WIDTH + ATTN_WIDTH + MLSTM_WIDTH

kernel_name = 'hybrid_s5_gqa_mlstm_dit_block'


def rmsnorm(x, w):
    xf = x.astype(jnp.float32)
    y = xf * lax.rsqrt(jnp.mean(xf * xf, axis=-1, keepdims=True) + EPS)
    return (y * w.astype(jnp.float32)).astype(x.dtype)


def split_sections(p):
    bounds = []
    acc = 0
    for s in SECTION_SIZES[:-1]:
        acc += s
        bounds.append(acc)
    return jnp.split(p, bounds, axis=-1)


def maybe_flip(t, flip, axis):
    return jnp.flip(t, axis=axis) if flip else t


def axial_rope_tables(n_tokens):
    rows = n_tokens // GRID_W
    row = jnp.broadcast_to(jnp.arange(rows, dtype=jnp.float32)[:, None], (rows, GRID_W)).reshape(-1)
    col = jnp.broadcast_to(jnp.arange(GRID_W, dtype=jnp.float32)[None, :], (rows, GRID_W)).reshape(-1)
    n_freq = HEAD_DIM // 4
    inv = ROPE_THETA ** (-jnp.arange(n_freq, dtype=jnp.float32) / n_freq)
    ang = jnp.concatenate([row[:, None] * inv, col[:, None] * inv], axis=-1)
    return jnp.cos(ang), jnp.sin(ang)


def apply_rope(x, cos, sin):
    half = x.shape[-1] // 2
    x1, x2 = x[..., :half], x[..., half:]
    cs, sn = cos[None, :, None, :], sin[None, :, None, :]
    return jnp.concatenate([x1 * cs - x2 * sn, x1 * sn + x2 * cs], axis=-1).astype(x.dtype)


def s5_discretize(a_re, a_im, log_dt, b_re, b_im):
    a_re = a_re.astype(jnp.float32)
    a_im = a_im.astype(jnp.float32)
    dt = jnp.exp(log_dt.astype(jnp.float32))[:, None]
    mag = jnp.exp(a_re * dt)
    lam_re = mag * jnp.cos(a_im * dt)
    lam_im = mag * jnp.sin(a_im * dt)
    inv_abs2 = 1.0 / (a_re * a_re + a_im * a_im)
    num_re, num_im = lam_re - 1.0, lam_im
    f_re = (num_re * a_re + num_im * a_im) * inv_abs2
    f_im = (num_im * a_re - num_re * a_im) * inv_abs2
    b_re = b_re.astype(jnp.float32)
    b_im = b_im.astype(jnp.float32)
    bb_re = f_re[:, None, :] * b_re - f_im[:, None, :] * b_im
    bb_im = f_re[:, None, :] * b_im + f_im[:, None, :] * b_re
    return lam_re, lam_im, bb_re, bb_im


def complex_affine_combine(e1, e2):
    a1r, a1i, b1r, b1i = e1
    a2r, a2i, b2r, b2i = e2
    return (a1r * a2r - a1i * a2i,
            a1r * a2i + a1i * a2r,
            a2r * b1r - a2i * b1i + b2r,
            a2r * b1i + a2i * b1r + b2i)


def s5_scan(u, h_re, h_im, lam_re, lam_im, bb_re, bb_im, c_re, c_im):
    n = u.shape[1]
    x_re = jnp.einsum('blgp,gpn->blgn', u, bb_re)
    x_im = jnp.einsum('blgp,gpn->blgn', u, bb_im)
    x_re = x_re.at[:, 0].add(lam_re * h_re - lam_im * h_im)
    x_im = x_im.at[:, 0].add(lam_re * h_im + lam_im * h_re)
    a_re = jnp.broadcast_to(lam_re, (1, n) + lam_re.shape)
    a_im = jnp.broadcast_to(lam_im, (1, n) + lam_im.shape)
    _, _, s_re, s_im = lax.associative_scan(complex_affine_combine, (a_re, a_im, x_re, x_im), axis=1)
    y = (jnp.einsum('blgn,gpn->blgp', s_re, c_re.astype(jnp.float32))
         - jnp.einsum('blgn,gpn->blgp', s_im, c_im.astype(jnp.float32)))
    return y, s_re[:, -1], s_im[:, -1]


def s5_branch(u_lat, z_lat, u_ctx, z_ctx, a_re, a_im, log_dt, b_re, b_im, c_re, c_im, d, w_glu, need_ctx):
    def grp(t):
        return t.astype(jnp.float32).reshape(t.shape[0], t.shape[1], SSM_GROUPS, SSM_GROUP)
    ul, uc = grp(u_lat), grp(u_ctx)
    d_g = d.astype(jnp.float32).reshape(SSM_GROUPS, SSM_GROUP)
    y_lat = d_g * ul
    y_ctx = d_g * uc if need_ctx else None
    bsz = ul.shape[0]
    for direction in range(2):
        rev = direction == 1
        lam_re, lam_im, bb_re, bb_im = s5_discretize(a_re[direction], a_im[direction], log_dt[direction], b_re, b_im)
        zero = jnp.zeros((bsz, SSM_GROUPS, SSM_STATE), jnp.float32)
        yc, h_re, h_im = s5_scan(maybe_flip(uc, rev, 1), zero, zero, lam_re, lam_im, bb_re, bb_im,
                                 c_re[direction], c_im[direction])
        yl, _, _ = s5_scan(maybe_flip(ul, rev, 1), h_re, h_im, lam_re, lam_im, bb_re, bb_im,
                           c_re[direction], c_im[direction])
        y_lat = y_lat + maybe_flip(yl, rev, 1)
        if need_ctx:
            y_ctx = y_ctx + maybe_flip(yc, rev, 1)

    def glu_out(y, z):
        g = jax.nn.gelu(y.reshape(y.shape[0], y.shape[1], SSM_WIDTH)).astype(z.dtype)
        return g * jax.nn.sigmoid(g @ w_glu) * jax.nn.silu(z)

    out_ctx = glu_out(y_ctx, z_ctx) if need_ctx else None
    return glu_out(y_lat, z_lat), out_ctx


def gqa_attend(q, keys, vals):
    s = jnp.einsum('bqkgd,bskd->bkgqs', q, keys).astype(jnp.float32) * (HEAD_DIM ** -0.5)
    p = jax.nn.softmax(s, axis=-1).astype(vals.dtype)
    return jnp.einsum('bkgqs,bskd->bqkgd', p, vals)


def attention_branch(q, k, v, z, q_c, k_c, v_c, z_c, q_norm_w, k_norm_w, cos, sin, need_ctx):
    bsz, n, _ = q.shape
    grp = ATTN_HEADS // ATTN_KV_HEADS

    def heads(t, nh):
        return t.reshape(t.shape[0], t.shape[1], nh, HEAD_DIM)

    ql = apply_rope(rmsnorm(heads(q, ATTN_HEADS), q_norm_w), cos, sin)
    kl = apply_rope(rmsnorm(heads(k, ATTN_KV_HEADS), k_norm_w), cos, sin)
    kc = rmsnorm(heads(k_c, ATTN_KV_HEADS), k_norm_w)
    vc = heads(v_c, ATTN_KV_HEADS)
    keys = jnp.concatenate([kc, kl], axis=1)
    vals = jnp.concatenate([vc, heads(v, ATTN_KV_HEADS)], axis=1)
    nb = n // Q_BLOCK
    qb = ql.reshape(bsz, nb, Q_BLOCK, ATTN_KV_HEADS, grp, HEAD_DIM).swapaxes(0, 1)
    o = lax.map(lambda blk: gqa_attend(blk, keys, vals), qb)
    o = o.swapaxes(0, 1).reshape(bsz, n, ATTN_WIDTH)
    out_lat = o * jax.nn.silu(z)
    out_ctx = None
    if need_ctx:
        qc = rmsnorm(heads(q_c, ATTN_HEADS), q_norm_w)
        qc = qc.reshape(bsz, qc.shape[1], ATTN_KV_HEADS, grp, HEAD_DIM)
        oc = gqa_attend(qc, kc, vc).reshape(bsz, qc.shape[1], ATTN_WIDTH)
        out_ctx = oc * jax.nn.silu(z_c)
    return out_lat, out_ctx


def centred_dwconv(x, w, b):
    pad = CONV_WIDTH // 2
    y = lax.conv_general_dilated(x, w[:, None, :].astype(x.dtype), window_strides=(1,),
                                 padding=[(pad, pad)], dimension_numbers=('NWC', 'WIO', 'NWC'),
                                 feature_group_count=x.shape[-1])
    return y + b


def mlstm_inputs(q, k, v, g, conv_w, conv_b, gate_b):
    qk = jax.nn.silu(centred_dwconv(jnp.concatenate([q, k], axis=-1), conv_w, conv_b))
    q, k = jnp.split(qk, 2, axis=-1)
    bsz, n, _ = q.shape

    def heads(t):
        return t.astype(jnp.float32).reshape(bsz, n, MLSTM_HEADS, MLSTM_HEAD_DIM).transpose(0, 2, 1, 3)

    gates = (g + gate_b).astype(jnp.float32).reshape(bsz, n, 4, MLSTM_HEADS).transpose(2, 0, 3, 1)
    return heads(q), heads(k), heads(v), gates


def mlstm_scan(q, k, v, i_pre, f_pre, state):
    bsz, nh, n, dh = q.shape
    nc = n // MLSTM_CHUNK

    def to_chunks(t):
        return jnp.moveaxis(t.reshape(t.shape[:2] + (nc, MLSTM_CHUNK) + t.shape[3:]), 2, 0)

    qs, ks, vs = to_chunks(q), to_chunks(k * (dh ** -0.5)), to_chunks(v)
    log_f = to_chunks(jax.nn.log_sigmoid(f_pre))
    log_i = to_chunks(i_pre)
    lower = jnp.tril(jnp.ones((MLSTM_CHUNK, MLSTM_CHUNK), dtype=bool))

    def step(carry, inp):
        c_st, n_st, m_st = carry
        qc, kc, vc, lf, li = inp
        b = jnp.cumsum(lf, axis=-1)
        log_d = jnp.where(lower, b[..., :, None] - b[..., None, :] + li[..., None, :], -jnp.inf)
        inter = b + m_st[..., None]
        m_t = jnp.maximum(inter, jnp.max(log_d, axis=-1))
        s = jnp.einsum('bhtd,bhsd->bhts', qc, kc) * jnp.exp(log_d - m_t[..., None])
        w_inter = jnp.exp(inter - m_t)
        num = jnp.einsum('bhts,bhse->bhte', s, vc) + w_inter[..., None] * jnp.einsum('bhed,bhtd->bhte', c_st, qc)
        den = jnp.sum(s, axis=-1) + w_inter * jnp.einsum('bhtd,bhd->bht', qc, n_st)
        h = num / jnp.maximum(jnp.abs(den), jnp.exp(-m_t))[..., None]
        b_last = b[..., -1]
        log_w = b_last[..., None] - b + li
        m_new = jnp.maximum(b_last + m_st, jnp.max(log_w, axis=-1))
        w = jnp.exp(log_w - m_new[..., None])
        decay = jnp.exp(b_last + m_st - m_new)
        c_new = decay[..., None, None] * c_st + jnp.einsum('bhs,bhse,bhsd->bhed', w, vc, kc)
        n_new = decay[..., None] * n_st + jnp.einsum('bhs,bhsd->bhd', w, kc)
        return (c_new, n_new, m_new), h

    state, hs = lax.scan(step, state, (qs, ks, vs, log_f, log_i))
    return jnp.moveaxis(hs, 0, 2).reshape(bsz, nh, n, dh), state


def mlstm_branch(q, k, v, o, g, z, q_c, k_c, v_c, o_c, g_c, z_c, conv_w, conv_b, gate_b, norm_w, need_ctx):
    ql, kl, vl, gl = mlstm_inputs(q, k, v, g, conv_w, conv_b, gate_b)
    qc, kc, vc, gc = mlstm_inputs(q_c, k_c, v_c, g_c, conv_w, conv_b, gate_b)
    bsz = ql.shape[0]
    h_lat = None
    h_ctx = None
    for direction in range(2):
        rev = direction == 1
        state0 = (jnp.zeros((bsz, MLSTM_HEADS, MLSTM_HEAD_DIM, MLSTM_HEAD_DIM), jnp.float32),
                  jnp.zeros((bsz, MLSTM_HEADS, MLSTM_HEAD_DIM), jnp.float32),
                  jnp.zeros((bsz, MLSTM_HEADS), jnp.float32))
        hc, st = mlstm_scan(maybe_flip(qc, rev, 2), maybe_flip(kc, rev, 2), maybe_flip(vc, rev, 2),
                            maybe_flip(gc[2 * direction], rev, 2), maybe_flip(gc[2 * direction + 1], rev, 2), state0)
        hl, _ = mlstm_scan(maybe_flip(ql, rev, 2), maybe_flip(kl, rev, 2), maybe_flip(vl, rev, 2),
                           maybe_flip(gl[2 * direction], rev, 2), maybe_flip(gl[2 * direction + 1], rev, 2), st)
        hl = maybe_flip(hl, rev, 2)
        h_lat = hl if h_lat is None else h_lat + hl
        if need_ctx:
            hc = maybe_flip(hc, rev, 2)
            h_ctx = hc if h_ctx is None else h_ctx + hc

    def out(h, og, zg):
        bsz_, nh, n, dh = h.shape
        hn = rmsnorm(h.transpose(0, 2, 1, 3), norm_w.reshape(nh, dh)).reshape(bsz_, n, MLSTM_WIDTH)
        return (jax.nn.sigmoid(og.astype(jnp.float32)) * hn * jax.nn.silu(zg.astype(jnp.float32))).astype(zg.dtype)

    out_ctx = out(h_ctx, o_c, z_c) if need_ctx else None
    return out(h_lat, o, z), out_ctx


def setup_inputs(seed: int = 0) -> dict:
    key = jax.random.key(seed)
    ks = jax.random.split(key, 26)
    f32 = jnp.float32

    def nrm(k, shape, s):
        return s * jax.random.normal(k, shape, f32)

    D = D_MODEL
    f_bias = jnp.linspace(3.0, 6.0, MLSTM_HEADS, dtype=f32)
    zb = jnp.zeros_like(f_bias)
    gate_base = jnp.stack([zb, f_bias, zb, f_bias])
    a_im_base = jnp.pi * jnp.arange(SSM_STATE, dtype=f32)
    return {
        'x': nrm(ks[0], (BATCH, SEQ, D), 1.0),
        'c': nrm(ks[1], (BATCH, D), 1.0),
        'ctx': nrm(ks[2], (BATCH, CTX_LEN, D), 1.0),
        'c_ctx': nrm(ks[3], (D,), 1.0),
        'norm_w': 1.0 + nrm(ks[4], (DEPTH, D), 0.02),
        'ada_w': nrm(ks[5], (DEPTH, D, 3 * D), 0.5 * D ** -0.5),
        'ada_b': nrm(ks[6], (DEPTH, 3 * D), 0.02),
        'w_in': nrm(ks[7], (DEPTH, D, IN_COLS), D ** -0.5),
        'mlstm_gate_b': (gate_base[None] + nrm(ks[8], (DEPTH, 4, MLSTM_HEADS), 0.1)).reshape(DEPTH, N_GATES),
        'ssm_a_re': -0.5 + nrm(ks[9], (DEPTH, 2, SSM_GROUPS, SSM_STATE), 0.01),
        'ssm_a_im': a_im_base + nrm(ks[10], (DEPTH, 2, SSM_GROUPS, SSM_STATE), 0.01),
        'ssm_log_dt': jax.random.uniform(ks[11], (DEPTH, 2, SSM_GROUPS), f32,
                                         minval=math.log(DT_MIN), maxval=math.log(DT_MAX)),
        'ssm_b_re': nrm(ks[12], (DEPTH, SSM_GROUPS, SSM_GROUP, SSM_STATE), (2 * SSM_GROUP) ** -0.5),
        'ssm_b_im': nrm(ks[13], (DEPTH, SSM_GROUPS, SSM_GROUP, SSM_STATE), (2 * SSM_GROUP) ** -0.5),
        'ssm_c_re': nrm(ks[14], (DEPTH, 2, SSM_GROUPS, SSM_GROUP, SSM_STATE), (2 * SSM_STATE) ** -0.5),
        'ssm_c_im': nrm(ks[15], (DEPTH, 2, SSM_GROUPS, SSM_GROUP, SSM_STATE), (2 * SSM_STATE) ** -0.5),
        'ssm_d': nrm(ks[16], (DEPTH, SSM_WIDTH), 1.0),
        'ssm_w_glu': nrm(ks[17], (DEPTH, SSM_WIDTH, SSM_WIDTH), SSM_WIDTH ** -0.5),
        'attn_q_norm': 1.0 + nrm(ks[18], (DEPTH, HEAD_DIM), 0.02),
        'attn_k_norm': 1.0 + nrm(ks[19], (DEPTH, HEAD_DIM), 0.02),
        'mlstm_conv_w': nrm(ks[20], (DEPTH, CONV_WIDTH, 2 * MLSTM_WIDTH), CONV_WIDTH ** -0.5),
        'mlstm_conv_b': nrm(ks[21], (DEPTH, 2 * MLSTM_WIDTH), 0.02),
        'mlstm_norm_w': 1.0 + nrm(ks[22], (DEPTH, MLSTM_WIDTH), 0.02),
        'w_out': nrm(ks[23], (DEPTH, MIX_WIDTH, D), MIX_WIDTH ** -0.5),
        'final_norm_w': 1.0 + nrm(ks[24], (D,), 0.02),
    }


def reference(x, c, ctx, c_ctx, norm_w, ada_w, ada_b, w_in, mlstm_gate_b, ssm_a_re, ssm_a_im, ssm_log_dt,
              ssm_b_re, ssm_b_im, ssm_c_re, ssm_c_im, ssm_d, ssm_w_glu, attn_q_norm, attn_k_norm,
              mlstm_conv_w, mlstm_conv_b, mlstm_norm_w, w_out, final_norm_w):
    n_lat = x.shape[1]
    cos, sin = axial_rope_tables(n_lat)
    c_act = jax.nn.silu(c)
    cc_act = jax.nn.silu(c_ctx)
    h_lat, h_ctx = x, ctx
    for layer in range(DEPTH):
        need_ctx = layer < DEPTH - 1
        shift, scale, gate = jnp.split(c_act @ ada_w[layer] + ada_b[layer], 3, axis=-1)
        shift_c, scale_c, gate_c = jnp.split(cc_act @ ada_w[layer] + ada_b[layer], 3, axis=-1)
        xn = rmsnorm(h_lat, norm_w[layer]) * (1.0 + scale[:, None]) + shift[:, None]
        xc = rmsnorm(h_ctx, norm_w[layer]) * (1.0 + scale_c) + shift_c
        (s5_u, s5_z, at_q, at_k, at_v, at_z,
         ml_q, ml_k, ml_v, ml_o, ml_g, ml_z) = split_sections(xn @ w_in[layer])
        (s5_uc, s5_zc, at_qc, at_kc, at_vc, at_zc,
         ml_qc, ml_kc, ml_vc, ml_oc, ml_gc, ml_zc) = split_sections(xc @ w_in[layer])
        ya, ya_c = s5_branch(s5_u, s5_z, s5_uc, s5_zc, ssm_a_re[layer], ssm_a_im[layer], ssm_log_dt[layer],
                             ssm_b_re[layer], ssm_b_im[layer], ssm_c_re[layer], ssm_c_im[layer],
                             ssm_d[layer], ssm_w_glu[layer], need_ctx)
        yb, yb_c = attention_branch(at_q, at_k, at_v, at_z, at_qc, at_kc, at_vc, at_zc,
                                    attn_q_norm[layer], attn_k_norm[layer], cos, sin, need_ctx)
        yc, yc_c = mlstm_branch(ml_q, ml_k, ml_v, ml_o, ml_g, ml_z, ml_qc, ml_kc, ml_vc, ml_oc, ml_gc, ml_zc,
                                mlstm_conv_w[layer], mlstm_conv_b[layer], mlstm_gate_b[layer],
                                mlstm_norm_w[layer], need_ctx)
        h_lat = h_lat + gate[:, None] * (jnp.concatenate([ya, yb, yc], axis=-1) @ w_out[layer])
        if need_ctx:
            h_ctx = h_ctx + gate_c * (jnp.concatenate([ya_c, yb_c, yc_c], axis=-1) @ w_out[layer])
    return rmsnorm(h_lat, final_norm_w)
```

```cpp
#include <hip/hip_runtime.h>
#include <hip/hip_cooperative_groups.h>
#include <hip/hip_bf16.h>
#include <cstdio>
#include <cstdint>
#include <cmath>
namespace cg = cooperative_groups;

constexpr int DM = 2048, NBATCH = 2, SEQ = 8192, CTX = 256, RB = SEQ + CTX  , NROWS = NBATCH * RB  ;
constexpr int NCOL_IN = 6160, NPROJ = 6400;
constexpr int NCH = RB / 128;
constexpr float EPSN = 1e-6f;
namespace pg8 {
#define PG8_LAS __attribute__((address_space(3)))
typedef unsigned short bf16_t;
typedef short bf16x8 __attribute__((ext_vector_type(8)));
typedef float f32x4 __attribute__((ext_vector_type(4)));
typedef unsigned u32x4 __attribute__((ext_vector_type(4)));
constexpr int BM = 256, BK = 64, HALF = 128, HTB = HALF * BK * 2  , STAGE_BYTES = 8 * HTB, NXCD = 8, WGM = 8;

__host__ __device__ __forceinline__ int lds_byte(int r, int c) { const int st = (r >> 4) * 2 + (c >> 5), rr = r & 15, cc = c & 31, ob = rr * 64 + cc * 2; return st * 1024 + (ob ^ (((ob >> 9) & 1) << 5)); }
__host__ __device__ __forceinline__ void stage_rc(int b, int& R, int& C) { const int st = b / 1024, sb = b % 1024, swz = sb ^ (((sb >> 9) & 1) << 5); R = (st >> 1) * 16 + swz / 64; C = (st & 1) * 32 + (swz % 64) / 2; }
__host__ __device__ __forceinline__ int perm32(int rho) { const int n = rho >> 4, i = rho & 15; return 8 * (i >> 2) + 4 * n + (i & 3); }

struct Unit { int pm, pn; };
struct Gemm { const bf16_t* A; const bf16_t* Bt; int M, N, K; };

struct StaticOrder {
    int nM, nN, nwg, G, c, lat_only;
    __host__ __device__ void init(int nM_, int nN_, int G_, int c_, int lat_only_) { nM = nM_; nN = nN_; nwg = nM * nN; G = G_; c = c_; lat_only = lat_only_; }
    __host__ __device__ bool next(int i, Unit& u) const {
        const long L = (long)i * G + c; if (L >= nwg) return false;
        int wgid = (int)L; { const int q = nwg / NXCD, r = nwg % NXCD, xcd = wgid % NXCD, off = wgid / NXCD; wgid = (xcd < r ? xcd * (q + 1) : r * (q + 1) + (xcd - r) * q) + off; }
        const int nig = WGM * nN, gid = wgid / nig, fm = gid * WGM, gsz = (nM - fm) < WGM ? (nM - fm) : WGM;
        int pm = fm + ((wgid % nig) % gsz); u.pn = (wgid % nig) / gsz;
        if (lat_only) pm = pm + 1 + (pm >= 32 ? 1 : 0);
        u.pm = pm; return true;
    }
    __device__ __forceinline__ void a_ready(const Unit&) const {}
    __device__ __forceinline__ void done(const Unit&) const {}
};
__device__ __forceinline__ unsigned cvt_pk_bf16(float lo, float hi) { unsigned r; asm volatile("v_cvt_pk_bf16_f32 %0, %1, %2" : "=v"(r) : "v"(lo), "v"(hi)); return r; }
typedef float f32x2 __attribute__((ext_vector_type(2)));
__device__ __forceinline__ float bf2f(unsigned short b) { return __uint_as_float(((unsigned)b) << 16); }
__device__ __forceinline__ float sigmoidf_(float x) { return 1.0f / (1.0f + __expf(-x)); }
__device__ __forceinline__ float siluf_(float x) { return x / (1.0f + __expf(-x)); }
struct EpiProj {
    static constexpr bool PERM = true, AFTER_DRAIN = false;
    bf16_t* proj; float* graw;
    __device__ __forceinline__ void operator()(const f32x4 (&acc)[2][2][4][2], const Unit& u, int wr, int wc, int fr, int fq) const {
        const int row0 = u.pm * BM + wr * 64 + fr; const int cst = u.pn * BM;
        if (cst >= 6144) {
            if (wc == 0 && fq < 2) {
#pragma unroll
                for (int ai = 0; ai < 2; ++ai)
#pragma unroll
                    for (int m = 0; m < 4; ++m) { float* gp = graw + (size_t)(row0 + ai * HALF + m * 16) * 16 + 8 * fq; *(f32x4*)gp = acc[ai][0][m][0]; *(f32x4*)(gp + 4) = acc[ai][0][m][1]; }
            }
            return;
        }
        int ss, ld;
        if (cst < 512) { ss = 0; ld = 512; } else if (cst < 1024) { ss = 512; ld = 512; } else if (cst < 2048) { ss = 1024; ld = 1024; } else if (cst < 2304) { ss = 2048; ld = 256; }
        else if (cst < 2560) { ss = 2304; ld = 256; } else if (cst < 3584) { ss = 2560; ld = 1024; } else { ss = 3584 + ((cst - 3584) >> 9) * 512; ld = 512; }
        bf16_t* base = proj + (size_t)NROWS * ss; const int col0 = cst - ss + wc * 32 + 8 * fq;
#pragma unroll
        for (int ai = 0; ai < 2; ++ai)
#pragma unroll
            for (int m = 0; m < 4; ++m) { bf16_t* rowp = base + (size_t)(row0 + ai * HALF + m * 16) * ld + col0;
#pragma unroll
                for (int bj = 0; bj < 2; ++bj) { const f32x4 v0 = acc[ai][bj][m][0], v1 = acc[ai][bj][m][1];
                    u32x4 w; w.x = cvt_pk_bf16(v0[0], v0[1]); w.y = cvt_pk_bf16(v0[2], v0[3]); w.z = cvt_pk_bf16(v1[0], v1[1]); w.w = cvt_pk_bf16(v1[2], v1[3]);
                    *(u32x4*)(rowp + bj * HALF) = w; } }
    }
};
struct EpiGlu {
    static constexpr bool PERM = true, AFTER_DRAIN = false;
    const bf16_t* G; const bf16_t* Z; bf16_t* MIX;
    __device__ __forceinline__ void operator()(const f32x4 (&acc)[2][2][4][2], const Unit& u, int wr, int wc, int fr, int fq) const {
        const int row0 = u.pm * BM + wr * 64 + fr; const int col0 = u.pn * BM + wc * 32 + 8 * fq;
#pragma unroll
        for (int ai = 0; ai < 2; ++ai)
#pragma unroll
            for (int m = 0; m < 4; ++m) { const size_t row = (size_t)(row0 + ai * HALF + m * 16);
#pragma unroll
                for (int bj = 0; bj < 2; ++bj) { const int c = col0 + bj * HALF;
                    const u32x4 gw = *(const u32x4*)(G + row * 512 + c), zw = *(const u32x4*)(Z + row * 512 + c);
                    const f32x4 v0 = acc[ai][bj][m][0], v1 = acc[ai][bj][m][1];
                    float o[8];
#pragma unroll
                    for (int e = 0; e < 8; ++e) { const unsigned gq = gw[e >> 1], zq = zw[e >> 1];
                        const float g = (e & 1) ? __uint_as_float(gq & 0xffff0000u) : __uint_as_float(gq << 16);
                        const float z = (e & 1) ? __uint_as_float(zq & 0xffff0000u) : __uint_as_float(zq << 16);
                        const float a = e < 4 ? v0[e & 3] : v1[e & 3];
                        o[e] = g * sigmoidf_(a) * siluf_(z); }
                    u32x4 w; w.x = cvt_pk_bf16(o[0], o[1]); w.y = cvt_pk_bf16(o[2], o[3]); w.z = cvt_pk_bf16(o[4], o[5]); w.w = cvt_pk_bf16(o[6], o[7]);
                    *(u32x4*)(MIX + row * 2048 + c) = w; } }
    }
};
struct EpiOut {
    static constexpr bool PERM = false, AFTER_DRAIN = false;
    const float* lat_src; const float* ctx_src; float* lat_dst; float* ctx_dst; const float* ada;
    __device__ __forceinline__ void operator()(const f32x4 (&acc)[2][2][4][2], const Unit& u, int wr, int wc, int fr, int fq) const {
        const int b = u.pm / 33, j = u.pm % 33; const bool isc = (j == 0);
        const size_t roff = isc ? (size_t)(b * CTX) * DM : (size_t)(b * SEQ + (j - 1) * 256) * DM;
        const float* src = (isc ? ctx_src : lat_src) + roff; float* dst = (isc ? ctx_dst : lat_dst) + roff;
        const float* gate = ada + (isc ? 2 : b) * 6144 + 4096;
        const int col0 = u.pn * BM + wc * 32 + 4 * fq;
#pragma unroll
        for (int bj = 0; bj < 2; ++bj)
#pragma unroll
            for (int n = 0; n < 2; ++n) { const int c = col0 + bj * HALF + n * 16; const f32x4 gv = *(const f32x4*)(gate + c);
#pragma unroll
                for (int ai = 0; ai < 2; ++ai)
#pragma unroll
                    for (int m = 0; m < 4; ++m) { const size_t off = (size_t)(ai * HALF + wr * 64 + m * 16 + fr) * DM + c;
                        const f32x4 hv = *(const f32x4*)(src + off); *(f32x4*)(dst + off) = hv + gv * acc[ai][bj][m][n]; } }
    }
};
template <class Epi, class Sched, bool ALIGN_EPI = false, bool SP2 = false>
__device__ __forceinline__ void gemm_phase(PG8_LAS unsigned char* lds, const Gemm g, const Sched& S, const Epi& E) {
    int tid_ = threadIdx.x; asm volatile("" : "+v"(tid_));
    const int tid = tid_, wid = __builtin_amdgcn_readfirstlane(tid >> 6), lane = tid & 63, wr = wid >> 2, wc = wid & 3, fr = lane & 15, fq = lane >> 4;
    const int K = g.K, nt = K / BK;
    unsigned voffA[2], voffB[2];
#pragma unroll
    for (int i = 0; i < 2; ++i) { int R, C; stage_rc(tid * 16 + i * 8192, R, C); const int Rb = Epi::PERM ? ((R & ~31) + perm32(R & 31)) : R;
        voffA[i] = (unsigned)(R * K + C) * 2u; voffB[i] = (unsigned)(Rb * K + C) * 2u; }
    const size_t kstep = (size_t)(BK * 2);
    const size_t hstep = (size_t)HALF * K * 2;
    const size_t tstep = 2 * hstep;
    const unsigned ldsw = (unsigned)wid * 1024u;
    const int aoff = lds_byte(wr * 64 + fr, fq * 8), boff = lds_byte(wc * 32 + fr, fq * 8);
#define PG8_SA(b, h) (((b) * 2 + (h)) * HTB)
#define PG8_SB(b, h) ((4 + (b) * 2 + (h)) * HTB)
#define PG8_STAGE(bufoff, gbase, voff) do { _Pragma("unroll") for (int _i = 0; _i < 2; ++_i) \
        __builtin_amdgcn_global_load_lds((const unsigned*)((const char*)(gbase) + (voff)[_i]), (PG8_LAS unsigned*)(lds + (bufoff) + ldsw + _i * 8192), 16, 0, 0); } while (0)
#define PG8_LDA(dst, b, h) do { _Pragma("unroll") for (int m = 0; m < 4; ++m) _Pragma("unroll") for (int k = 0; k < 2; ++k) dst[m][k] = *(const PG8_LAS bf16x8*)(lds + PG8_SA(b, h) + aoff + m * 2048 + k * 1024); } while (0)
#define PG8_LDB(dst, b, h) do { _Pragma("unroll") for (int n = 0; n < 2; ++n) _Pragma("unroll") for (int k = 0; k < 2; ++k) dst[n][k] = *(const PG8_LAS bf16x8*)(lds + PG8_SB(b, h) + boff + n * 2048 + k * 1024); } while (0)
#define PG8_MMA(ai, bj, At, Bt) do { __builtin_amdgcn_s_setprio(1); _Pragma("unroll") for (int m = 0; m < 4; ++m) _Pragma("unroll") for (int n = 0; n < 2; ++n) _Pragma("unroll") for (int k = 0; k < 2; ++k) \
        acc[ai][bj][m][n] = __builtin_amdgcn_mfma_f32_16x16x32_bf16(Bt[n][k], At[m][k], acc[ai][bj][m][n], 0, 0, 0); __builtin_amdgcn_s_setprio(0); } while (0)
#define PG8_WAIT_V(n) asm volatile("s_waitcnt vmcnt(" #n ")" ::: "memory")
#define PG8_WAIT_L(n) asm volatile("s_waitcnt lgkmcnt(" #n ")" ::: "memory")
#define PG8_BAR __builtin_amdgcn_s_barrier()
#define PG8_SCHED __builtin_amdgcn_sched_barrier(0)
    Unit cur, nxt; int ui = 0;
    if (!S.next(0, cur)) return;
    f32x4 acc[2][2][4][2];
#pragma unroll
    for (int a = 0; a < 2; ++a)
#pragma unroll
        for (int b = 0; b < 2; ++b)
#pragma unroll
            for (int m = 0; m < 4; ++m)
#pragma unroll
                for (int n = 0; n < 2; ++n) acc[a][b][m][n] = (f32x4){0.f, 0.f, 0.f, 0.f};
    bf16x8 At[4][2], B0[2][2], B1[2][2];
    const char* cA = (const char*)g.A + (size_t)cur.pm * tstep; const char* cB = (const char*)g.Bt + (size_t)cur.pn * tstep;
    S.a_ready(cur);
    if constexpr (SP2) {
        PG8_STAGE(PG8_SB(0, 0), cB, voffB); PG8_STAGE(PG8_SB(0, 1), cB + hstep, voffB); PG8_STAGE(PG8_SA(0, 0), cA, voffA); PG8_STAGE(PG8_SA(0, 1), cA + hstep, voffA);
        if (wr == 1) PG8_BAR;
        PG8_WAIT_V(2); PG8_BAR;
        PG8_STAGE(PG8_SB(1, 0), cB + kstep, voffB); PG8_STAGE(PG8_SA(1, 0), cA + kstep, voffA); PG8_STAGE(PG8_SB(1, 1), cB + hstep + kstep, voffB);
        PG8_WAIT_V(6); PG8_BAR;
    } else {
        PG8_STAGE(PG8_SB(0, 0), cB, voffB); PG8_STAGE(PG8_SA(0, 0), cA, voffA); PG8_STAGE(PG8_SB(0, 1), cB + hstep, voffB); PG8_STAGE(PG8_SA(0, 1), cA + hstep, voffA);
        if (wr == 1) PG8_BAR;
        PG8_WAIT_V(4); PG8_BAR;
        PG8_STAGE(PG8_SB(1, 0), cB + kstep, voffB); PG8_STAGE(PG8_SA(1, 0), cA + kstep, voffA); PG8_STAGE(PG8_SB(1, 1), cB + hstep + kstep, voffB);
        PG8_WAIT_V(6); PG8_BAR;
    }
    for (;;) {
        const bool has_next = S.next(ui + 1, nxt);
        const char* nA = has_next ? (const char*)g.A + (size_t)nxt.pm * tstep : cA; const char* nB = has_next ? (const char*)g.Bt + (size_t)nxt.pn * tstep : cB;
        for (int t = 0; t < nt; t += 2) {
            const bool last = (t == nt - 2);
            const char* a1 = cA + (size_t)(t + 1) * kstep;
            const char* a2 = last ? nA : cA + (size_t)(t + 2) * kstep; const char* b2 = last ? nB : cB + (size_t)(t + 2) * kstep;
            const char* a3 = a2 + kstep; const char* b3 = b2 + kstep;
            if (last && has_next) S.a_ready(nxt);
            if constexpr (SP2) {
            PG8_LDB(B0, 0, 0); PG8_LDB(B1, 0, 1); PG8_SCHED; PG8_LDA(At, 0, 0); PG8_STAGE(PG8_SA(1, 1), a1 + hstep, voffA);
            PG8_WAIT_V(8); PG8_WAIT_L(0); PG8_BAR; PG8_MMA(0, 0, At, B0); PG8_MMA(0, 1, At, B1); PG8_BAR; PG8_SCHED;
            PG8_LDA(At, 0, 1); PG8_STAGE(PG8_SB(0, 0), b2, voffB); PG8_STAGE(PG8_SB(0, 1), b2 + hstep, voffB); PG8_STAGE(PG8_SA(0, 0), a2, voffA);
            PG8_WAIT_V(8); PG8_WAIT_L(0); PG8_BAR; PG8_MMA(1, 0, At, B0); PG8_MMA(1, 1, At, B1); PG8_BAR; PG8_SCHED;
            PG8_LDB(B0, 1, 0); PG8_LDB(B1, 1, 1); PG8_SCHED; PG8_LDA(At, 1, 0); PG8_STAGE(PG8_SA(0, 1), a2 + hstep, voffA);
            PG8_WAIT_V(8); PG8_WAIT_L(0); PG8_BAR; PG8_MMA(0, 0, At, B0); PG8_MMA(0, 1, At, B1); PG8_BAR; PG8_SCHED;
            PG8_LDA(At, 1, 1); PG8_STAGE(PG8_SB(1, 0), b3, voffB); PG8_STAGE(PG8_SB(1, 1), b3 + hstep, voffB); PG8_STAGE(PG8_SA(1, 0), a3, voffA);
            PG8_WAIT_V(8); PG8_WAIT_L(0); PG8_BAR; PG8_MMA(1, 0, At, B0); PG8_MMA(1, 1, At, B1); PG8_BAR; PG8_SCHED;
            } else {
            PG8_LDB(B0, 0, 0); PG8_SCHED; PG8_LDA(At, 0, 0); PG8_STAGE(PG8_SA(1, 1), a1 + hstep, voffA);
            PG8_WAIT_L(8); PG8_BAR; PG8_WAIT_L(0); PG8_MMA(0, 0, At, B0); PG8_BAR; PG8_SCHED;
            PG8_LDB(B1, 0, 1); PG8_STAGE(PG8_SB(0, 0), b2, voffB);
            PG8_BAR; PG8_WAIT_L(0); PG8_MMA(0, 1, At, B1); PG8_BAR;
            PG8_LDA(At, 0, 1); PG8_STAGE(PG8_SA(0, 0), a2, voffA);
            PG8_BAR; PG8_WAIT_L(0); PG8_MMA(1, 0, At, B0); PG8_BAR; PG8_SCHED;
            PG8_STAGE(PG8_SB(0, 1), b2 + hstep, voffB);
            PG8_WAIT_V(6); PG8_BAR; PG8_MMA(1, 1, At, B1); PG8_BAR;
            PG8_LDB(B0, 1, 0); PG8_SCHED; PG8_LDA(At, 1, 0); PG8_STAGE(PG8_SA(0, 1), a2 + hstep, voffA);
            PG8_WAIT_L(8); PG8_BAR; PG8_WAIT_L(0); PG8_MMA(0, 0, At, B0); PG8_BAR; PG8_SCHED;
            PG8_LDB(B1, 1, 1); PG8_STAGE(PG8_SB(1, 0), b3, voffB);
            PG8_BAR; PG8_WAIT_L(0); PG8_MMA(0, 1, At, B1); PG8_BAR;
            PG8_LDA(At, 1, 1); PG8_STAGE(PG8_SA(1, 0), a3, voffA);
            PG8_BAR; PG8_WAIT_L(0); PG8_MMA(1, 0, At, B0); PG8_BAR; PG8_SCHED;
            PG8_STAGE(PG8_SB(1, 1), b3 + hstep, voffB);
            PG8_WAIT_V(6); PG8_BAR; PG8_MMA(1, 1, At, B1); PG8_BAR;
            }
        }
        if constexpr (ALIGN_EPI) { if (wr == 0) PG8_BAR; }
        if constexpr (!Epi::AFTER_DRAIN) { E(acc, cur, wr, wc, fr, fq); S.done(cur); }
        if (!has_next) break;
#pragma unroll
        for (int a = 0; a < 2; ++a)
#pragma unroll
            for (int b = 0; b < 2; ++b)
#pragma unroll
                for (int m = 0; m < 4; ++m)
#pragma unroll
                    for (int n = 0; n < 2; ++n) acc[a][b][m][n] = (f32x4){0.f, 0.f, 0.f, 0.f};
        cur = nxt; cA = nA; cB = nB; ++ui;
        if constexpr (ALIGN_EPI) { if (wr == 1) PG8_BAR; }
    }
    PG8_WAIT_V(0);
    if constexpr (!ALIGN_EPI) { if (wr == 0) PG8_BAR; }
    PG8_BAR;
    if constexpr (Epi::AFTER_DRAIN) { E.fused(acc, cur, wr, wc, fr, fq, lds, wid, lane); S.done(cur); }
#undef PG8_SA
#undef PG8_SB
#undef PG8_STAGE
#undef PG8_LDA
#undef PG8_LDB
#undef PG8_MMA
#undef PG8_WAIT_V
#undef PG8_WAIT_L
#undef PG8_BAR
#undef PG8_SCHED
}
}
namespace attn {
using bf16 = unsigned short;
constexpr int D = 128, NW = 8, QBLK = 32, KVBLK = 64;
constexpr float SCALE = 0.088388347648318440f;
constexpr float THR = 8.f;
constexpr int SDEPTH = 2;
constexpr int LDQ = 1024, LDK = 256, LDZ = 1024, LDM = 2048;
constexpr size_t SHM_V = KVBLK * D * 2, SHM_K = KVBLK * D * 2, SHM_ATTN = 2 * SHM_V + 2 * SHM_K + NW * 64 * 4;
using bf16x8 = __attribute__((ext_vector_type(8))) short;
using s16x4  = __attribute__((ext_vector_type(4))) short;
using f32x16 = __attribute__((ext_vector_type(16))) float;
using f32x8  = __attribute__((ext_vector_type(8))) float;
using u32x4  = __attribute__((ext_vector_type(4))) unsigned;
#define KSWZ(row, colB) ((row) * 256 + ((colB) ^ (((row) & 7) << 4)))
#define SBAR() __builtin_amdgcn_sched_barrier(0)
__device__ __forceinline__ int crow(int r, int hi) { return (r & 3) + 8 * (r >> 2) + 4 * hi; }
__device__ __forceinline__ unsigned cvtpk(float lo, float hi) {
  unsigned r; asm volatile("v_cvt_pk_bf16_f32 %0, %1, %2" : "=v"(r) : "v"(lo), "v"(hi)); return r;
}

__device__ __forceinline__ void partialSM(f32x16& p0, f32x16& p1, float& m_reg, float& mn, float& alpha) {
  constexpr float C = SCALE * 1.4426950408889634f;
  float pmax = p0[0]; for (int r = 1; r < 16; ++r) pmax = fmaxf(pmax, p0[r]); for (int r = 0; r < 16; ++r) pmax = fmaxf(pmax, p1[r]);
  { auto rr = __builtin_amdgcn_permlane32_swap(__float_as_uint(pmax), __float_as_uint(pmax), false, false);
    pmax = fmaxf(__uint_as_float(rr[0]), __uint_as_float(rr[1])); }
  if (__builtin_expect(__all(pmax - m_reg <= THR / SCALE), 1)) { mn = m_reg; alpha = 1.f; }
  else { mn = fmaxf(m_reg, pmax); alpha = __builtin_amdgcn_exp2f((m_reg - mn) * C); m_reg = mn; }
  float mnC = -mn * C;
  for (int r = 0; r < 16; ++r) p0[r] = fmaf(p0[r], C, mnC); for (int r = 0; r < 16; ++r) p1[r] = fmaf(p1[r], C, mnC);
  for (int r = 0; r < 16; ++r) p0[r] = __builtin_amdgcn_exp2f(p0[r]);
}
__device__ __forceinline__ void finishSM(f32x16& p0, f32x16& p1, float alpha, float& l_reg, bf16x8& pa0, bf16x8& pa1, bf16x8& pa2, bf16x8& pa3) {
  for (int r = 0; r < 16; ++r) p1[r] = __builtin_amdgcn_exp2f(p1[r]);
  float ps = 0; for (int r = 0; r < 16; ++r) ps += p0[r]; for (int r = 0; r < 16; ++r) ps += p1[r];
  { auto rr = __builtin_amdgcn_permlane32_swap(__float_as_uint(ps), __float_as_uint(ps), false, false);
    ps = __uint_as_float(rr[0]) + __uint_as_float(rr[1]); }
  l_reg = l_reg * alpha + ps;
#define PK4(P, BASE, OUT) do { unsigned a0 = cvtpk(P[BASE + 0], P[BASE + 1]), a1 = cvtpk(P[BASE + 2], P[BASE + 3]);   \
    unsigned b0 = cvtpk(P[BASE + 4], P[BASE + 5]), b1 = cvtpk(P[BASE + 6], P[BASE + 7]);                              \
    auto r0 = __builtin_amdgcn_permlane32_swap(a0, b0, false, false); auto r1 = __builtin_amdgcn_permlane32_swap(a1, b1, false, false); \
    u32x4 w = {r0[0], r1[0], r0[1], r1[1]}; OUT = *reinterpret_cast<bf16x8*>(&w); } while (0)
  PK4(p0, 0, pa0); PK4(p0, 8, pa1); PK4(p1, 0, pa2); PK4(p1, 8, pa3);
#undef PK4
}
__device__ __forceinline__ void qkt(f32x16& p0, f32x16& p1, const bf16* Ks, const bf16x8* qr, int r32, int hi) {
  p0 = f32x16{}; p1 = f32x16{};
  for (int d0 = 0; d0 < 8; ++d0) { int cb = (d0 * 16 + hi * 8) * 2;
    bf16x8 b0 = *reinterpret_cast<const bf16x8*>((const char*)Ks + KSWZ(r32, cb));
    bf16x8 b1 = *reinterpret_cast<const bf16x8*>((const char*)Ks + KSWZ(32 + r32, cb));
    p0 = __builtin_amdgcn_mfma_f32_32x32x16_bf16(b0, qr[d0], p0, 0, 0, 0);
    p1 = __builtin_amdgcn_mfma_f32_32x32x16_bf16(b1, qr[d0], p1, 0, 0, 0); }
}
__device__ __forceinline__ int v_st(int k, int c) { const int kk = (k & ~0xC) | ((k & 4) << 1) | ((k & 8) >> 1); return ((kk >> 3) * 4 + (c >> 5)) * 512 + ((kk & 7) * 32 + (c & 31)) * 2; }
__device__ __forceinline__ int v_rd_base(int lane) { return ((lane & 3) << 3) | (((lane >> 2) & 3) << 6) | (((lane >> 4) & 1) << 5) | (((lane >> 5) & 1) << 8); }
constexpr int v_rd_off(int d0, int ks, int half) { return d0 * 512 + ks * 4096 + half * 2048; }
template <int OFF> __device__ __forceinline__ s16x4 tr_read(int vb) {
  s16x4 r; asm volatile("ds_read_b64_tr_b16 %0, %1 offset:%2" : "=&v"(r) : "v"(vb), "i"(OFF) : "memory"); return r;
}
template <int D0> __device__ __forceinline__ void pv_one(f32x16& od, int vb, bf16x8 pa0, bf16x8 pa1, bf16x8 pa2, bf16x8 pa3) {
  const s16x4 l0 = tr_read<v_rd_off(D0, 0, 0)>(vb), h0 = tr_read<v_rd_off(D0, 0, 1)>(vb), l1 = tr_read<v_rd_off(D0, 1, 0)>(vb), h1 = tr_read<v_rd_off(D0, 1, 1)>(vb);
  const s16x4 l2 = tr_read<v_rd_off(D0, 2, 0)>(vb), h2 = tr_read<v_rd_off(D0, 2, 1)>(vb), l3 = tr_read<v_rd_off(D0, 3, 0)>(vb), h3 = tr_read<v_rd_off(D0, 3, 1)>(vb);
  asm volatile("s_waitcnt lgkmcnt(0)" ::: "memory"); SBAR();
#define PK(L, H) (bf16x8){L[0], L[1], L[2], L[3], H[0], H[1], H[2], H[3]}
  od = __builtin_amdgcn_mfma_f32_32x32x16_bf16(pa0, PK(l0, h0), od, 0, 0, 0);
  od = __builtin_amdgcn_mfma_f32_32x32x16_bf16(pa1, PK(l1, h1), od, 0, 0, 0);
  od = __builtin_amdgcn_mfma_f32_32x32x16_bf16(pa2, PK(l2, h2), od, 0, 0, 0);
  od = __builtin_amdgcn_mfma_f32_32x32x16_bf16(pa3, PK(l3, h3), od, 0, 0, 0);
#undef PK
}
__device__ __forceinline__ void pv_d0(f32x16* o, int vb, bf16x8 pa0, bf16x8 pa1, bf16x8 pa2, bf16x8 pa3) {
  pv_one<0>(o[0], vb, pa0, pa1, pa2, pa3); pv_one<1>(o[1], vb, pa0, pa1, pa2, pa3); pv_one<2>(o[2], vb, pa0, pa1, pa2, pa3); pv_one<3>(o[3], vb, pa0, pa1, pa2, pa3);
}
__device__ __forceinline__ bf16x8 ld8(const bf16* p) { return *reinterpret_cast<const bf16x8*>(p); }
__device__ __forceinline__ void attn_dense_body(const bf16* __restrict__ Qb, const bf16* __restrict__ Kh, const bf16* __restrict__ Vh,
                                                const bf16* __restrict__ Zb, bf16* __restrict__ Mb, int seq, char* lds) {
  int tid_ = threadIdx.x; asm volatile("" : "+v"(tid_));
  const int tid = tid_, wid = tid >> 6, lane = tid & 63, r32 = lane & 31, hi = lane >> 5;
  bf16* V_lds = (bf16*)lds; bf16* K_lds = (bf16*)(lds + 2 * SHM_V);
  float* ws = (float*)(lds + 2 * SHM_V + 2 * SHM_K) + wid * 64; float* li_l = ws; float* al_l = ws + 32;
  float m_reg = -1e30f, l_reg = 0; f32x16 o[4] = {}; bf16x8 qr[8];
  const bf16* Qw = Qb + (long)(wid * QBLK + r32) * LDQ + hi * 8;
#pragma unroll
  for (int d0 = 0; d0 < 8; ++d0) qr[d0] = ld8(Qw + d0 * 16);
  const int sr = tid >> 4, sc = (tid & 15) * 8, vst0 = v_st(sr, sc), vst1 = v_st(32 + sr, sc);
  const int vb0 = (int)(uintptr_t)V_lds + v_rd_base(lane);
  struct { bf16x8 vs0, vs1, ks0, ks1; } sr_[SDEPTH];
#define SLOAD(i, k0) do { sr_[i].vs0 = ld8(&Vh[(long)((k0) + sr) * LDK + sc]); sr_[i].vs1 = ld8(&Vh[(long)((k0) + 32 + sr) * LDK + sc]); \
    sr_[i].ks0 = ld8(&Kh[(long)((k0) + sr) * LDK + sc]); sr_[i].ks1 = ld8(&Kh[(long)((k0) + 32 + sr) * LDK + sc]); } while (0)
#define SWRITE(b, i) do { *(bf16x8*)((char*)V_lds + (b) * SHM_V + vst0) = sr_[i].vs0;          \
    *(bf16x8*)((char*)V_lds + (b) * SHM_V + vst1) = sr_[i].vs1; int kc = sc * 2;               \
    *(bf16x8*)((char*)K_lds + (b) * SHM_K + KSWZ(sr, kc)) = sr_[i].ks0;                       \
    *(bf16x8*)((char*)K_lds + (b) * SHM_K + KSWZ(32 + sr, kc)) = sr_[i].ks1; } while (0)
#define SWAIT() do { if constexpr (SDEPTH == 2) asm volatile("s_waitcnt vmcnt(4)" ::: "memory"); else asm volatile("s_waitcnt vmcnt(0)" ::: "memory"); } while (0)
#define RESC(a) do { if (__any((a) < 1.f)) { if (hi == 0) al_l[r32] = (a); asm volatile("s_waitcnt lgkmcnt(0)" ::: "memory"); \
    for (int d = 0; d < 4; ++d) for (int r = 0; r < 16; ++r) o[d][r] *= al_l[crow(r, hi)]; } } while (0)
  f32x16 pA0, pA1, pB0, pB1; float mnA, mnB, alA, alB; bf16x8 pa0, pa1, pa2, pa3; const int NT = seq / KVBLK;
  constexpr int SE = 0, SO = SDEPTH - 1;
  SLOAD(SE, 0); asm volatile("s_waitcnt vmcnt(0)" ::: "memory"); SWRITE(0, SE); __syncthreads();
  qkt(pA0, pA1, K_lds, qr, r32, hi); partialSM(pA0, pA1, m_reg, mnA, alA);
  SLOAD(SO, KVBLK); if constexpr (SDEPTH == 2) { if (2 < NT) SLOAD(SE, 2 * KVBLK); }
  SWAIT(); SWRITE(1, SO); __syncthreads();
  for (int j = 1; j + 1 < NT; j += 2) {
    SBAR(); qkt(pB0, pB1, (bf16*)((char*)K_lds + SHM_K), qr, r32, hi);
    finishSM(pA0, pA1, alA, l_reg, pa0, pa1, pa2, pa3); SBAR();
    SLOAD(SO, (j + SDEPTH) * KVBLK); SBAR();
    pv_d0(o, vb0, pa0, pa1, pa2, pa3); partialSM(pB0, pB1, m_reg, mnB, alB);
    __syncthreads(); SWAIT(); SWRITE(0, SE);
    RESC(alB); __syncthreads();
    SBAR(); qkt(pA0, pA1, K_lds, qr, r32, hi);
    finishSM(pB0, pB1, alB, l_reg, pa0, pa1, pa2, pa3); SBAR();
    if (SDEPTH == 1 || j + 3 < NT) SLOAD(SE, (j + 1 + SDEPTH) * KVBLK); SBAR();
    pv_d0(o, vb0 + (int)SHM_V, pa0, pa1, pa2, pa3); partialSM(pA0, pA1, m_reg, mnA, alA);
    __syncthreads(); SWAIT(); SWRITE(1, SO);
    RESC(alA); __syncthreads();
  }
  SBAR(); qkt(pB0, pB1, (bf16*)((char*)K_lds + SHM_K), qr, r32, hi);
  finishSM(pA0, pA1, alA, l_reg, pa0, pa1, pa2, pa3); SBAR();
  pv_d0(o, vb0, pa0, pa1, pa2, pa3); partialSM(pB0, pB1, m_reg, mnB, alB);
  __syncthreads(); RESC(alB);
  finishSM(pB0, pB1, alB, l_reg, pa0, pa1, pa2, pa3); SBAR();
  pv_d0(o, vb0 + (int)SHM_V, pa0, pa1, pa2, pa3);
  if (hi == 0) li_l[r32] = l_reg; asm volatile("s_waitcnt lgkmcnt(0)" ::: "memory");
  float rli[16];
#pragma unroll
  for (int r = 0; r < 16; ++r) rli[r] = __builtin_amdgcn_rcpf(li_l[crow(r, hi)]);
  const bf16* Zw = Zb + (long)(wid * QBLK) * LDZ; bf16* Mw = Mb + (long)(wid * QBLK) * LDM;
#pragma unroll
  for (int r = 0; r < 16; ++r) { const int orow = crow(r, hi); asm volatile("" ::: "memory");
#pragma unroll
    for (int d0 = 0; d0 < 4; ++d0) { const float z = __uint_as_float(((unsigned)Zw[(long)orow * LDZ + d0 * 32 + r32]) << 16);
      const float v = o[d0][r] * rli[r] * (z / (1.0f + __expf(-z)));
      const unsigned u = __float_as_uint(v); Mw[(long)orow * LDM + d0 * 32 + r32] = (bf16)((u + 0x7fffu + ((u >> 16) & 1u)) >> 16); } }
  __syncthreads();
#undef SLOAD
#undef SWRITE
#undef SWAIT
#undef RESC
}
#undef KSWZ
#undef SBAR
}
typedef unsigned short bf16_t;
typedef short bf16x8 __attribute__((ext_vector_type(8)));
typedef float f32x4 __attribute__((ext_vector_type(4)));
typedef float f32x8 __attribute__((ext_vector_type(8)));
typedef unsigned u32x4 __attribute__((ext_vector_type(4)));
typedef unsigned u32x2 __attribute__((ext_vector_type(2)));
#define LAS __attribute__((address_space(3)))
constexpr size_t al256(size_t x) { return (x + 255) / 256 * 256; }
constexpr size_t W_WIN = 1u << 20;
constexpr size_t SZ_WIN = (size_t)NPROJ * DM * 2, SZ_WOUT = (size_t)DM * DM * 2, SZ_WGLU = (size_t)512 * 512 * 2;
constexpr size_t W_WOUT = W_WIN + 2 * SZ_WIN;
constexpr size_t W_WGLU = W_WOUT + 2 * SZ_WOUT;
constexpr size_t W_XN = W_WGLU + 2 * SZ_WGLU;
constexpr size_t W_PROJ = W_XN + (size_t)NROWS * DM * 2;
constexpr size_t W_GRAW = W_PROJ + (size_t)NROWS * 6144 * 2;
constexpr size_t W_GD = W_GRAW + (size_t)NROWS * 16 * 4;
constexpr size_t W_CQ = W_GD + (size_t)NROWS * 16 * 4;
constexpr size_t W_CK = W_CQ + (size_t)NROWS * 512 * 2;
constexpr size_t W_STC = W_CK + (size_t)NROWS * 512 * 2;
constexpr size_t W_STN = W_STC + (size_t)16 * 66 * 16384 * 4;
constexpr size_t W_STS = W_STN + (size_t)16 * 66 * 128 * 4;
constexpr size_t W_S5F = W_STS + al256(16 * 66 * 4 * 4);
constexpr size_t W_HCTX = W_S5F + (size_t)2 * 32 * 2 * 66 * 128 * 4;
constexpr size_t W_ROPE = W_HCTX + (size_t)512 * DM * 4;
constexpr size_t W_ADAP = W_ROPE + (size_t)SEQ * 64 * 2 * 4;
constexpr size_t W_ADA = W_ADAP + (size_t)2 * 32 * 3 * 6144 * 4;
constexpr size_t W_LAM = W_ADA + (size_t)2 * 3 * 6144 * 4;
constexpr size_t W_LAMT = W_LAM + (size_t)2 * 2 * 32 * 64 * 2 * 4;
constexpr size_t W_BBT = W_LAMT + (size_t)2 * 2 * 32 * 64 * 2 * 4;
constexpr size_t W_CMT = W_BBT + (size_t)2 * 2 * 32 * 128 * 16 * 4;
constexpr size_t W_END = W_CMT + (size_t)2 * 2 * 32 * 128 * 16 * 4;
static_assert(W_END <= (size_t)512 * 1024 * 1024, "workspace map exceeds 512 MiB");
constexpr int SEC_S5U = 0, SEC_S5Z = 512, SEC_ATQ = 1024, SEC_ATK = 2048, SEC_ATV = 2304, SEC_ATZ = 2560, SEC_MLQ = 3584, SEC_MLK = 4096, SEC_MLV = 4608, SEC_MLO = 5120, SEC_MLZ = 5632;
constexpr int LDS_BYTES = 147456;
constexpr int NTHR = 512;

struct Params { const float* in[25]; float* out; unsigned char* ws; };
enum { I_X = 0, I_C, I_CTX, I_CCTX, I_NORMW, I_ADAW, I_ADAB, I_WIN, I_GATEB, I_ARE, I_AIM, I_LOGDT, I_BRE, I_BIM, I_CRE, I_CIM, I_SSMD, I_WGLU, I_QNORM, I_KNORM, I_CONVW, I_CONVB, I_MNORM, I_WOUT, I_FNORM };

__device__ __forceinline__ float bf2f(unsigned short b) { return __uint_as_float(((unsigned)b) << 16); }
__device__ __forceinline__ unsigned short f2bf(float f) { unsigned u = __float_as_uint(f); return (unsigned short)((u + 0x7fffu + ((u >> 16) & 1u)) >> 16); }
__device__ __forceinline__ unsigned pk2(float lo, float hi) { return (unsigned)f2bf(lo) | ((unsigned)f2bf(hi) << 16); }
__device__ __forceinline__ float lo16(unsigned w) { return __uint_as_float(w << 16); }
__device__ __forceinline__ float hi16(unsigned w) { return __uint_as_float(w & 0xffff0000u); }
__device__ __forceinline__ float sigm(float x) { return 1.0f / (1.0f + __expf(-x)); }
__device__ __forceinline__ float silu(float x) { return x / (1.0f + __expf(-x)); }
__device__ __forceinline__ float wave_sum(float v) {
#pragma unroll
    for (int o = 1; o < 64; o <<= 1) v += __shfl_xor(v, o);
    return v;
}
__device__ __forceinline__ float gelu_tanh(float x) { const float u = 0.7978845608028654f * (x + 0.044715f * x * x * x); return 0.5f * x * (1.0f + tanhf(u)); }

__device__ __forceinline__ int win_col_map(int n) { return n < 5632 ? n : (n < 6144 ? n + 16 : (n < 6160 ? n - 512 : -1)); }
__device__ __forceinline__ void transpose_item(const float* W, int K, int N, bf16_t* WT, int nNew, bool remap, float* scr, int item, int lane) {
    const int nblk = nNew / 32, kb = item / nblk, nb = item % nblk, k0 = 64 * kb, n0 = 32 * nb;
    const int nn = n0 + (lane & 31); const int oc = remap ? win_col_map(nn) : nn;
#pragma unroll 8
    for (int i = 0; i < 32; ++i) { const int kk = 2 * i + (lane >> 5); scr[kk * 33 + (lane & 31)] = oc >= 0 ? W[(size_t)(k0 + kk) * N + oc] : 0.f; }
    asm volatile("s_waitcnt lgkmcnt(0)" ::: "memory");
    const int c = lane & 7;
#pragma unroll
    for (int j = 0; j < 4; ++j) { const int n = (lane >> 3) + 8 * j; const float* s = scr + (8 * c) * 33 + n;
        u32x4 o; o.x = pk2(s[0 * 33], s[1 * 33]); o.y = pk2(s[2 * 33], s[3 * 33]); o.z = pk2(s[4 * 33], s[5 * 33]); o.w = pk2(s[6 * 33], s[7 * 33]);
        *(u32x4*)(WT + (size_t)(n0 + n) * K + k0 + 8 * c) = o; }
    asm volatile("s_waitcnt lgkmcnt(0)" ::: "memory");
}
__device__ __forceinline__ void p0_prologue(const Params& p, char* lds, int G) {
    unsigned char* ws = p.ws;
    int tid_o = threadIdx.x; asm volatile("" : "+v"(tid_o)); const int tid = tid_o, lane = tid & 63, wave = tid >> 6;
    const int gw = blockIdx.x * 8 + wave, NGW = G * 8;
    const int gt = blockIdx.x * NTHR + tid, NGT = G * NTHR;
    {
        float* act = (float*)lds;
        float* part = (float*)(ws + W_ADAP);
        for (int it = blockIdx.x; it < 2 * 32 * 12; it += G) {
            const int l = it / 384, rem = it % 384, ks = rem / 12, cc = rem % 12, j = cc * 512 + tid;
            __syncthreads();
            if (tid < 192) { const int v = tid >> 6, kk = tid & 63, k = ks * 64 + kk; const float cv = (v < 2) ? p.in[I_C][v * DM + k] : p.in[I_CCTX][k]; act[tid] = silu(cv); }
            __syncthreads();
            const float* W = p.in[I_ADAW] + (size_t)l * DM * 6144 + (size_t)(ks * 64) * 6144 + j;
            float a0 = 0.f, a1 = 0.f, a2 = 0.f;
#pragma unroll 8
            for (int kk = 0; kk < 64; ++kk) { const float w = W[(size_t)kk * 6144]; a0 += act[kk] * w; a1 += act[64 + kk] * w; a2 += act[128 + kk] * w; }
            float* po = part + (size_t)((l * 32 + ks) * 3) * 6144 + j;
            po[0] = a0; po[6144] = a1; po[2 * 6144] = a2;
        }
        __syncthreads();
    }
    {
        float* scr = (float*)(lds + wave * 8704);
        constexpr int I_IN = 32 * (NPROJ / 32), I_OUT = 32 * (DM / 32), I_GL = 8 * 16;
        constexpr int NIT = 2 * (I_IN + I_OUT + I_GL);
        for (int it = gw; it < NIT; it += NGW) {
            int r = it; const int l = r / (I_IN + I_OUT + I_GL); r -= l * (I_IN + I_OUT + I_GL);
            if (r < I_IN) { transpose_item(p.in[I_WIN] + (size_t)l * DM * NCOL_IN, DM, NCOL_IN, (bf16_t*)(ws + W_WIN + l * SZ_WIN), NPROJ, true, scr, r, lane); continue; } r -= I_IN;
            if (r < I_OUT) { transpose_item(p.in[I_WOUT] + (size_t)l * DM * DM, DM, DM, (bf16_t*)(ws + W_WOUT + l * SZ_WOUT), DM, false, scr, r, lane); continue; } r -= I_OUT;
            transpose_item(p.in[I_WGLU] + (size_t)l * 512 * 512, 512, 512, (bf16_t*)(ws + W_WGLU + l * SZ_WGLU), 512, false, scr, r, lane);
        }
    }
    for (int idx = gt; idx < 2 * 2 * 32 * 64; idx += NGT) {
        const int n = idx & 63, g = (idx >> 6) & 31, dir = (idx >> 11) & 1, l = idx >> 12;
        const int ld = l * 2 + dir;
        const float a_re = p.in[I_ARE][(ld * 32 + g) * 64 + n], a_im = p.in[I_AIM][(ld * 32 + g) * 64 + n];
        const float dt = expf(p.in[I_LOGDT][ld * 32 + g]);
        const float mag = expf(a_re * dt); const float lam_re = mag * cosf(a_im * dt), lam_im = mag * sinf(a_im * dt);
        const float inv = 1.0f / (a_re * a_re + a_im * a_im);
        const float nr = lam_re - 1.0f, ni = lam_im;
        const float f_re = (nr * a_re + ni * a_im) * inv, f_im = (ni * a_re - nr * a_im) * inv;
        float* LAM = (float*)(ws + W_LAM); float* LAMT = (float*)(ws + W_LAMT);
        LAM[idx * 2] = lam_re; LAM[idx * 2 + 1] = lam_im;
        { const double are = (double)a_re * (double)dt * 128.0, aim = (double)a_im * (double)dt * 128.0; const double mg = exp(are);
          LAMT[idx * 2] = (float)(mg * cos(aim)); LAMT[idx * 2 + 1] = (float)(mg * sin(aim)); }
        float* BBT = (float*)(ws + W_BBT) + (size_t)((ld * 32 + g) * 128) * 16;
        for (int q = 0; q < 16; ++q) { const float br = p.in[I_BRE][((l * 32 + g) * 16 + q) * 64 + n], bi = p.in[I_BIM][((l * 32 + g) * 16 + q) * 64 + n];
            BBT[n * 16 + q] = f_re * br - f_im * bi; BBT[(64 + n) * 16 + q] = f_re * bi + f_im * br; }
        float* CMT = (float*)(ws + W_CMT) + (size_t)((ld * 32 + g) * 16) * 128;
        for (int pp = 0; pp < 16; ++pp) { const float cr = p.in[I_CRE][((ld * 32 + g) * 16 + pp) * 64 + n], ci = p.in[I_CIM][((ld * 32 + g) * 16 + pp) * 64 + n];
            CMT[pp * 128 + n] = cr; CMT[pp * 128 + 64 + n] = -ci; }
    }
    for (int idx = gt; idx < SEQ * 64; idx += NGT) {
        const int t = idx >> 6, d = idx & 63; const float inv = exp2f(-(float)(d & 31) * (13.287712379549449f / 32.0f));
        const float pos = (d < 32) ? (float)(t >> 6) : (float)(t & 63); const float ang = pos * inv;
        float* RP = (float*)(ws + W_ROPE); RP[idx * 2] = cosf(ang); RP[idx * 2 + 1] = sinf(ang);
    }
}
__device__ __forceinline__ void p0b_ada(const Params& p, int G) {
    int tid_o = threadIdx.x; asm volatile("" : "+v"(tid_o)); const int gt = blockIdx.x * NTHR + tid_o, NGT = G * NTHR;
    const float* part = (const float*)(p.ws + W_ADAP); float* ada = (float*)(p.ws + W_ADA);
    for (int idx = gt; idx < 2 * 3 * 6144; idx += NGT) {
        const int l = idx / 18432, v = (idx / 6144) % 3, j = idx % 6144;
        float s = p.in[I_ADAB][l * 6144 + j];
        for (int ks = 0; ks < 32; ++ks) s += part[(size_t)((l * 32 + ks) * 3 + v) * 6144 + j];
        ada[idx] = s;
    }
}
__device__ __forceinline__ void p1_xn(const Params& p, int layer, int G) {
    int tid_o = threadIdx.x; asm volatile("" : "+v"(tid_o)); const int tid = tid_o, lane = tid & 63, wave = tid >> 6; const int gw = blockIdx.x * 8 + wave, NGW = G * 8;
    const float* ada = (const float*)(p.ws + W_ADA) + layer * 3 * 6144; const float* nw = p.in[I_NORMW] + layer * DM;
    bf16_t* XN = (bf16_t*)(p.ws + W_XN);
    for (int row = gw; row < NROWS; row += NGW) {
        const int b = row / RB, r = row % RB; const bool isc = r < CTX;
        const float* src = (layer == 0) ? (isc ? p.in[I_CTX] + (size_t)(b * CTX + r) * DM : p.in[I_X] + (size_t)(b * SEQ + r - CTX) * DM)
                                        : (isc ? (const float*)(p.ws + W_HCTX) + (size_t)(b * CTX + r) * DM : p.out + (size_t)(b * SEQ + r - CTX) * DM);
        const float* av = ada + (isc ? 2 : b) * 6144;
        f32x4 v[8]; float ss = 0.f;
#pragma unroll
        for (int j = 0; j < 8; ++j) { v[j] = *(const f32x4*)(src + 4 * lane + 256 * j); ss += (v[j].x * v[j].x + v[j].y * v[j].y) + (v[j].z * v[j].z + v[j].w * v[j].w); }
        const float rstd = rsqrtf(wave_sum(ss) * (1.0f / DM) + EPSN);
#pragma unroll
        for (int j = 0; j < 8; ++j) { const int c = 4 * lane + 256 * j; const f32x4 w = *(const f32x4*)(nw + c), sh = *(const f32x4*)(av + c), sc = *(const f32x4*)(av + 2048 + c);
            const f32x4 y = (v[j] * rstd * w) * (sc + 1.0f) + sh;
            u32x2 o; o.x = pk2(y.x, y.y); o.y = pk2(y.z, y.w); *(u32x2*)(XN + (size_t)row * DM + c) = o; }
    }
}
__device__ __forceinline__ void p_final(const Params& p, int G) {
    int tid_o = threadIdx.x; asm volatile("" : "+v"(tid_o)); const int tid = tid_o, lane = tid & 63, wave = tid >> 6; const int gw = blockIdx.x * 8 + wave, NGW = G * 8;
    const float* nw = p.in[I_FNORM];
    for (int row = gw; row < NBATCH * SEQ; row += NGW) {
        float* src = p.out + (size_t)row * DM;
        f32x4 v[8]; float ss = 0.f;
#pragma unroll
        for (int j = 0; j < 8; ++j) { v[j] = *(const f32x4*)(src + 4 * lane + 256 * j); ss += (v[j].x * v[j].x + v[j].y * v[j].y) + (v[j].z * v[j].z + v[j].w * v[j].w); }
        const float rstd = rsqrtf(wave_sum(ss) * (1.0f / DM) + EPSN);
#pragma unroll
        for (int j = 0; j < 8; ++j) { const int c = 4 * lane + 256 * j; const f32x4 w = *(const f32x4*)(nw + c); *(f32x4*)(src + c) = v[j] * rstd * w; }
    }
}
__device__ __forceinline__ void p3_post(const Params& p, int layer, int G) {
    unsigned char* ws = p.ws;
    int tid_o = threadIdx.x; asm volatile("" : "+v"(tid_o)); const int tid = tid_o, lane = tid & 63, wave = tid >> 6;
    const int gw = blockIdx.x * 8 + wave, NGW = G * 8;
    const int gt = blockIdx.x * NTHR + tid, NGT = G * NTHR;
    bf16_t* PROJ = (bf16_t*)(ws + W_PROJ);
    {
        bf16_t* ATQ = PROJ + (size_t)NROWS * SEC_ATQ; bf16_t* ATK = PROJ + (size_t)NROWS * SEC_ATK;
        const float* qnw = p.in[I_QNORM] + layer * 128; const float* knw = p.in[I_KNORM] + layer * 128;
        const float* RP = (const float*)(ws + W_ROPE);
        const int d0 = (lane & 7) * 8;
        for (long gi = (long)gw * 8 + (lane >> 3); gi < (long)NROWS * 10; gi += (long)NGW * 8) {
            const int row = (int)(gi / 10), slot = (int)(gi % 10);
            const int r = row % RB; const bool isc = r < CTX; const int t = r - CTX;
            bf16_t* ptr = slot < 8 ? ATQ + (size_t)row * 1024 + slot * 128 : ATK + (size_t)row * 256 + (slot - 8) * 128;
            const float* w = slot < 8 ? qnw : knw;
            const u32x4 a = *(const u32x4*)(ptr + d0), bq = *(const u32x4*)(ptr + 64 + d0);
            float x1[8], x2[8]; float ss = 0.f;
#pragma unroll
            for (int i = 0; i < 4; ++i) { x1[2 * i] = lo16(a[i]); x1[2 * i + 1] = hi16(a[i]); x2[2 * i] = lo16(bq[i]); x2[2 * i + 1] = hi16(bq[i]); }
#pragma unroll
            for (int i = 0; i < 8; ++i) ss += x1[i] * x1[i] + x2[i] * x2[i];
            ss += __shfl_xor(ss, 1); ss += __shfl_xor(ss, 2); ss += __shfl_xor(ss, 4);
            const float rstd = rsqrtf(ss * (1.0f / 128.0f) + EPSN);
            float o1[8], o2[8];
#pragma unroll
            for (int i = 0; i < 8; ++i) { const float y1 = x1[i] * rstd * w[d0 + i], y2 = x2[i] * rstd * w[64 + d0 + i];
                if (isc) { o1[i] = y1; o2[i] = y2; }
                else { const float cs = RP[((size_t)t * 64 + d0 + i) * 2], sn = RP[((size_t)t * 64 + d0 + i) * 2 + 1]; o1[i] = y1 * cs - y2 * sn; o2[i] = y1 * sn + y2 * cs; } }
            u32x4 wa, wb;
#pragma unroll
            for (int i = 0; i < 4; ++i) { wa[i] = pk2(o1[2 * i], o1[2 * i + 1]); wb[i] = pk2(o2[2 * i], o2[2 * i + 1]); }
            *(u32x4*)(ptr + d0) = wa; *(u32x4*)(ptr + 64 + d0) = wb;
        }
    }
    {
        const bf16_t* MLQ = PROJ + (size_t)NROWS * SEC_MLQ; const bf16_t* MLK = PROJ + (size_t)NROWS * SEC_MLK;
        bf16_t* CQ = (bf16_t*)(ws + W_CQ); bf16_t* CK = (bf16_t*)(ws + W_CK);
        const float* cw = p.in[I_CONVW] + layer * 3 * 1024; const float* cb = p.in[I_CONVB] + layer * 1024;
        for (long idx = gt; idx < (long)NROWS * 128; idx += NGT) {
            const int row = (int)(idx >> 7), cgp = (int)(idx & 127); const int which = cgp >> 6, c0 = (cgp & 63) * 8;
            const int r = row % RB; const bool isc = r < CTX; const int t = isc ? r : r - CTX, len = isc ? CTX : SEQ;
            const bf16_t* src = (which ? MLK : MLQ) + (size_t)row * 512 + c0;
            const u32x4 xc = *(const u32x4*)src;
            u32x4 xp = {0u, 0u, 0u, 0u}, xn = {0u, 0u, 0u, 0u};
            if (t > 0) xp = *(const u32x4*)(src - 512);
            if (t < len - 1) xn = *(const u32x4*)(src + 512);
            const int wc0 = which * 512 + c0; float o[8];
#pragma unroll
            for (int i = 0; i < 8; ++i) { const float a = (i & 1) ? hi16(xp[i >> 1]) : lo16(xp[i >> 1]), bq = (i & 1) ? hi16(xc[i >> 1]) : lo16(xc[i >> 1]), cq = (i & 1) ? hi16(xn[i >> 1]) : lo16(xn[i >> 1]);
                float y = cw[wc0 + i] * a + cw[1024 + wc0 + i] * bq + cw[2048 + wc0 + i] * cq + cb[wc0 + i];
                y = silu(y); if (which) y *= 0.08838834764831845f; o[i] = y; }
            u32x4 w; w.x = pk2(o[0], o[1]); w.y = pk2(o[2], o[3]); w.z = pk2(o[4], o[5]); w.w = pk2(o[6], o[7]);
            *(u32x4*)((which ? CK : CQ) + (size_t)row * 512 + c0) = w;
        }
    }
    {
        const float* graw = (const float*)(ws + W_GRAW); float* gd = (float*)(ws + W_GD); const float* gb = p.in[I_GATEB] + layer * 16;
        for (long idx = gt; idx < (long)NROWS * 16; idx += NGT) {
            const int j = (int)(idx & 15); const float x = graw[idx] + gb[j];
            float y = x;
            if ((j >> 2) & 1) y = fminf(x, 0.f) - log1pf(__expf(-fabsf(x)));
            gd[idx] = y;
        }
    }
}
__device__ __forceinline__ void p4_attn(const Params& p, int layer, int G, char* lds) {
    unsigned char* ws = p.ws; const bf16_t* PROJ = (const bf16_t*)(ws + W_PROJ); bf16_t* MIX = (bf16_t*)(ws + W_XN);
    const bf16_t* ATQ = PROJ + (size_t)NROWS * SEC_ATQ; const bf16_t* ATK = PROJ + (size_t)NROWS * SEC_ATK; const bf16_t* ATV = PROJ + (size_t)NROWS * SEC_ATV; const bf16_t* ATZ = PROJ + (size_t)NROWS * SEC_ATZ;
    const int bx = blockIdx.x; const int vcu = (G % 8 == 0) ? (bx % 8) * (G / 8) + bx / 8 : bx;
    const int nunits = 512 + (layer == 0 ? 16 : 0);
    for (int u = vcu; u < nunits; u += G) {
        int b, h, rowq, seq;
        if (u < 512) { const int combo = u >> 7, within = u & 127; b = combo >> 1; const int kvh = combo & 1; h = kvh * 4 + (within >> 5); const int qb = within & 31; rowq = b * RB + CTX + qb * 256; seq = RB; }
        else { const int v = u - 512; b = v >> 3; h = v & 7; rowq = b * RB; seq = CTX; }
        const int kvh = h >> 2; const size_t key0 = (size_t)b * RB;
        attn::attn_dense_body(ATQ + (size_t)rowq * 1024 + h * 128, ATK + key0 * 256 + kvh * 128, ATV + key0 * 256 + kvh * 128,
                              ATZ + (size_t)rowq * 1024 + h * 128, MIX + (size_t)rowq * 2048 + 512 + h * 128, seq, lds);
    }
}
__device__ __forceinline__ int chunk_at(int dir, int pos) { return dir == 0 ? pos : (pos < 2 ? 1 - pos : 67 - pos); }
constexpr int S5_XS = 132, S5_SS = 136, S5_WAVE_LDS = 16 * S5_XS * 4 + 16 * S5_SS * 2;
template <int DIR, bool PASS2>
__device__ __forceinline__ void s5_chunk_dir(const bf16_t* U  , const float* lam, const float* bbt, const float* cmt,
                                             float& sr, float& si, f32x4 (&yacc)[8], float* Xs, bf16_t* Ss, int lane) {
    const int fr = lane & 15, fq = lane >> 4;
    bf16x8 bfx[8], bfy[4];
#pragma unroll
    for (int ct = 0; ct < 8; ++ct) {
        if (fq < 2) { const f32x8 v = *(const f32x8*)(bbt + (ct * 16 + fr) * 16 + 8 * fq);
            u32x4 w; w.x = pk2(v[0], v[1]); w.y = pk2(v[2], v[3]); w.z = pk2(v[4], v[5]); w.w = pk2(v[6], v[7]); bfx[ct] = __builtin_bit_cast(bf16x8, w); }
        else bfx[ct] = (bf16x8){0, 0, 0, 0, 0, 0, 0, 0};
    }
    if (PASS2) {
#pragma unroll
        for (int kk = 0; kk < 4; ++kk) { const f32x8 v = *(const f32x8*)(cmt + fr * 128 + kk * 32 + 8 * fq);
            u32x4 w; w.x = pk2(v[0], v[1]); w.y = pk2(v[2], v[3]); w.z = pk2(v[4], v[5]); w.w = pk2(v[6], v[7]); bfy[kk] = __builtin_bit_cast(bf16x8, w); }
    }
    const float lr = lam[2 * lane], li = lam[2 * lane + 1];
#pragma unroll (PASS2 ? 8 : 1)
    for (int s_ = 0; s_ < 8; ++s_) {
        const int slab = DIR ? 7 - s_ : s_;
        bf16x8 au = (bf16x8){0, 0, 0, 0, 0, 0, 0, 0};
        if (fq < 2) au = *(const bf16x8*)(U + (size_t)(slab * 16 + fr) * 512 + 8 * fq);
#pragma unroll
        for (int ct = 0; ct < 8; ++ct) {
            const f32x4 x = __builtin_amdgcn_mfma_f32_16x16x32_bf16(au, bfx[ct], (f32x4){0.f, 0.f, 0.f, 0.f}, 0, 0, 0);
#pragma unroll
            for (int rg = 0; rg < 4; ++rg) Xs[(4 * fq + rg) * S5_XS + ct * 16 + fr] = x[rg];
        }
        asm volatile("s_waitcnt lgkmcnt(0)" ::: "memory");
        for (int tt = 0; tt < 16; ++tt) {
            const int t = DIR ? 15 - tt : tt;
            const float xr = Xs[t * S5_XS + lane], xi = Xs[t * S5_XS + 64 + lane];
            const float nr = lr * sr - li * si + xr, ni = lr * si + li * sr + xi; sr = nr; si = ni;
            if (PASS2) { Ss[t * S5_SS + lane] = f2bf(sr); Ss[t * S5_SS + 64 + lane] = f2bf(si); }
        }
        if (PASS2) {
            asm volatile("s_waitcnt lgkmcnt(0)" ::: "memory");
#pragma unroll
            for (int kk = 0; kk < 4; ++kk) { const bf16x8 as = *(const bf16x8*)(Ss + fr * S5_SS + kk * 32 + 8 * fq);
                yacc[slab] = __builtin_amdgcn_mfma_f32_16x16x32_bf16(as, bfy[kk], yacc[slab], 0, 0, 0); }
        }
        asm volatile("s_waitcnt lgkmcnt(0)" ::: "memory");
    }
}
__device__ __forceinline__ void s5_pass1(const Params& p, int layer, int G, char* lds) {
    unsigned char* ws = p.ws; int tid_o = threadIdx.x; asm volatile("" : "+v"(tid_o)); const int tid = tid_o, lane0 = tid & 63, wave = tid >> 6; const int gw = blockIdx.x * 8 + wave, NGW = G * 8;
    float* Xs = (float*)(lds + wave * S5_WAVE_LDS); bf16_t* Ss = (bf16_t*)(lds + wave * S5_WAVE_LDS + 16 * S5_XS * 4);
    const bf16_t* S5U = (const bf16_t*)(ws + W_PROJ) + (size_t)NROWS * SEC_S5U; float* F = (float*)(ws + W_S5F);
    for (int u = gw; u < 2 * 32 * 2 * NCH; u += NGW) {
        const int k = u % NCH, dir = (u / NCH) & 1, g = (u / (2 * NCH)) & 31, b = u / (2 * NCH * 32);
        int lane = lane0; asm volatile("" : "+v"(lane));
        const int ld = layer * 2 + dir;
        const float* lam = (const float*)(ws + W_LAM) + (size_t)((ld * 32 + g) * 64) * 2;
        const float* bbt = (const float*)(ws + W_BBT) + (size_t)((ld * 32 + g) * 128) * 16;
        const float* cmt = (const float*)(ws + W_CMT) + (size_t)((ld * 32 + g) * 16) * 128;
        const bf16_t* U = S5U + (size_t)(b * RB + k * 128) * 512 + g * 16;
        float sr = 0.f, si = 0.f; f32x4 yacc[8];
        if (dir == 0) s5_chunk_dir<0, false>(U, lam, bbt, cmt, sr, si, yacc, Xs, Ss, lane);
        else          s5_chunk_dir<1, false>(U, lam, bbt, cmt, sr, si, yacc, Xs, Ss, lane);
        float* Fo = F + ((size_t)((b * 32 + g) * 2 + dir) * NCH + k) * 128;
        Fo[lane] = sr; Fo[64 + lane] = si;
    }
}
__device__ __forceinline__ void s5_carry(const Params& p, int layer, int G) {
    unsigned char* ws = p.ws; int tid_o = threadIdx.x; asm volatile("" : "+v"(tid_o)); const int gt = blockIdx.x * NTHR + tid_o, NGT = G * NTHR;
    float* F = (float*)(ws + W_S5F);
    for (int idx = gt; idx < 2 * 32 * 2 * 64; idx += NGT) {
        const int n = idx & 63, dir = (idx >> 6) & 1, g = (idx >> 7) & 31, b = idx >> 12;
        const float* lt = (const float*)(ws + W_LAMT) + (size_t)(((layer * 2 + dir) * 32 + g) * 64 + n) * 2;
        const float lr = lt[0], li = lt[1];
        float* Fb = F + (size_t)((b * 32 + g) * 2 + dir) * NCH * 128;
        float sr = 0.f, si = 0.f;
        for (int p0 = 0; p0 < NCH; p0 += 11) {
            float fr_[11], fi_[11];
#pragma unroll
            for (int q = 0; q < 11; ++q) { const int k = chunk_at(dir, p0 + q); fr_[q] = Fb[k * 128 + n]; fi_[q] = Fb[k * 128 + 64 + n]; }
#pragma unroll
            for (int q = 0; q < 11; ++q) { const int k = chunk_at(dir, p0 + q); Fb[k * 128 + n] = sr; Fb[k * 128 + 64 + n] = si;
                const float nr = lr * sr - li * si + fr_[q], ni = lr * si + li * sr + fi_[q]; sr = nr; si = ni; }
        }
    }
}
__device__ __forceinline__ void s5_pass2(const Params& p, int layer, int G, char* lds) {
    unsigned char* ws = p.ws; int tid_o = threadIdx.x; asm volatile("" : "+v"(tid_o)); const int tid = tid_o, lane0 = tid & 63, wave = tid >> 6; const int gw = blockIdx.x * 8 + wave, NGW = G * 8;
    float* Xs = (float*)(lds + wave * S5_WAVE_LDS); bf16_t* Ss = (bf16_t*)(lds + wave * S5_WAVE_LDS + 16 * S5_XS * 4);
    bf16_t* S5U = (bf16_t*)(ws + W_PROJ) + (size_t)NROWS * SEC_S5U; const float* F = (const float*)(ws + W_S5F);
    const float* Dv = p.in[I_SSMD] + layer * 512;
    for (int u = gw; u < 2 * 32 * NCH; u += NGW) {
        const int k = u % NCH, g = (u / NCH) & 31, b = u / (NCH * 32);
        if (layer == 1 && k < 2) continue;
        int lane = lane0; asm volatile("" : "+v"(lane)); const int fr = lane & 15, fq = lane >> 4;
        bf16_t* U = S5U + (size_t)(b * RB + k * 128) * 512 + g * 16;
        f32x4 yacc[8];
#pragma unroll
        for (int s = 0; s < 8; ++s) yacc[s] = (f32x4){0.f, 0.f, 0.f, 0.f};
        {
            const int ld = layer * 2;
            const float* Fi = F + ((size_t)((b * 32 + g) * 2 + 0) * NCH + k) * 128; float sr = Fi[lane], si = Fi[64 + lane];
            s5_chunk_dir<0, true>(U, (const float*)(ws + W_LAM) + (size_t)((ld * 32 + g) * 64) * 2, (const float*)(ws + W_BBT) + (size_t)((ld * 32 + g) * 128) * 16,
                                  (const float*)(ws + W_CMT) + (size_t)((ld * 32 + g) * 16) * 128, sr, si, yacc, Xs, Ss, lane);
        }
        {
            const int ld = layer * 2 + 1;
            const float* Fi = F + ((size_t)((b * 32 + g) * 2 + 1) * NCH + k) * 128; float sr = Fi[lane], si = Fi[64 + lane];
            s5_chunk_dir<1, true>(U, (const float*)(ws + W_LAM) + (size_t)((ld * 32 + g) * 64) * 2, (const float*)(ws + W_BBT) + (size_t)((ld * 32 + g) * 128) * 16,
                                  (const float*)(ws + W_CMT) + (size_t)((ld * 32 + g) * 16) * 128, sr, si, yacc, Xs, Ss, lane);
        }
        const float dg = Dv[g * 16 + fr];
#pragma unroll
        for (int s = 0; s < 8; ++s)
#pragma unroll
            for (int rg = 0; rg < 4; ++rg) { bf16_t* up = U + (size_t)(s * 16 + 4 * fq + rg) * 512 + fr; const float y = yacc[s][rg] + dg * bf2f(*up); *up = f2bf(gelu_tanh(y)); }
    }
}
constexpr int LDP = 136;
constexpr int ML_X0 = 0, ML_X1 = 128 * LDP * 2, ML_X2 = 2 * 128 * LDP * 2, ML_VEC = 3 * 128 * LDP * 2;
__device__ __forceinline__ void bgemm128(const LAS bf16_t* A, const LAS bf16_t* Bt, f32x4 (&acc)[2][4], int wm, int wn, int fr, int fq) {
#pragma unroll
    for (int kk = 0; kk < 4; ++kk) {
        bf16x8 a[2], b[4];
#pragma unroll
        for (int i = 0; i < 2; ++i) a[i] = *(const LAS bf16x8*)(A + (wm * 32 + i * 16 + fr) * LDP + kk * 32 + 8 * fq);
#pragma unroll
        for (int j = 0; j < 4; ++j) b[j] = *(const LAS bf16x8*)(Bt + (wn * 64 + j * 16 + fr) * LDP + kk * 32 + 8 * fq);
#pragma unroll
        for (int i = 0; i < 2; ++i)
#pragma unroll
            for (int j = 0; j < 4; ++j) acc[i][j] = __builtin_amdgcn_mfma_f32_16x16x32_bf16(b[j], a[i], acc[i][j], 0, 0, 0);
    }
}
__device__ __forceinline__ void zero_acc(f32x4 (&acc)[2][4]) {
#pragma unroll
    for (int i = 0; i < 2; ++i)
#pragma unroll
        for (int j = 0; j < 4; ++j) acc[i][j] = (f32x4){0.f, 0.f, 0.f, 0.f};
}
__device__ __forceinline__ void gate_scan_b(int dir, const LAS float* lf, const LAS float* li, LAS float* bA, LAS float* aA, int tid) {
    if (tid < 128) { float bs = 0.f; const int lo = dir ? tid : 0, hi_ = dir ? 127 : tid;
#pragma unroll 1
        for (int s = lo; s <= hi_; ++s) bs += lf[s];
        bA[tid] = bs; aA[tid] = li[tid] - bs; }
}
__device__ __forceinline__ void ml_m1(const Params& p, int layer, int G, char* ldsc) {
    unsigned char* ws = p.ws; LAS unsigned char* lds = (LAS unsigned char*)ldsc;
    LAS bf16_t* X1 = (LAS bf16_t*)(lds + ML_X1); LAS bf16_t* X2 = (LAS bf16_t*)(lds + ML_X2); LAS float* vec = (LAS float*)(lds + ML_VEC);
    LAS float* lfA = vec; LAS float* liA = vec + 256; LAS float* bA = vec + 512; LAS float* aA = vec + 640; LAS float* scl = vec + 768;
    const bf16_t* MLV = (const bf16_t*)(ws + W_PROJ) + (size_t)NROWS * SEC_MLV; const bf16_t* CK = (const bf16_t*)(ws + W_CK); const float* GD = (const float*)(ws + W_GD);
    float* STC = (float*)(ws + W_STC); float* STN = (float*)(ws + W_STN); float* STS = (float*)(ws + W_STS);
    for (int u = blockIdx.x; u < 2 * 4 * NCH; u += G) {
        const int k = u % NCH, h = (u / NCH) & 3, b = u / (NCH * 4); const int row0 = b * RB + k * 128;
        int tid_ = threadIdx.x; asm volatile("" : "+v"(tid_));
        const int tid = tid_, lane = tid & 63, wid = tid >> 6, fr = lane & 15, fq = lane >> 4, wm = wid >> 1, wn = wid & 1;
        __syncthreads();
        for (int c = tid; c < 2048; c += NTHR) { const int r = c >> 4, ch = c & 15;
            const u32x4 v = *(const u32x4*)(MLV + (size_t)(row0 + r) * 512 + h * 128 + ch * 8);
#pragma unroll
            for (int i = 0; i < 8; ++i) X2[(ch * 8 + i) * LDP + r] = (bf16_t)((i & 1) ? (v[i >> 1] >> 16) : (v[i >> 1] & 0xffffu)); }
        { const int dir = tid >> 8, which = (tid >> 7) & 1, j = tid & 127; const float val = GD[(size_t)(row0 + j) * 16 + (2 * dir + which) * 4 + h]; (which ? lfA : liA)[dir * 128 + j] = val; }
        __syncthreads();
        for (int dir = 0; dir < 2; ++dir) {
            const int chain = (b * 4 + h) * 2 + dir;
            gate_scan_b(dir, lfA + dir * 128, liA + dir * 128, bA, aA, tid);
            __syncthreads();
            if (tid == 0) { float am = aA[0];
#pragma unroll 1
                for (int s = 1; s < 128; ++s) am = fmaxf(am, aA[s]); scl[0] = am; scl[1] = bA[dir ? 0 : 127]; }
            __syncthreads();
            const float amax = scl[0];
            for (int c = tid; c < 2048; c += NTHR) { const int r = c >> 4, ch = c & 15; const float w = __expf(aA[r] - amax);
                const u32x4 v = *(const u32x4*)(CK + (size_t)(row0 + r) * 512 + h * 128 + ch * 8);
#pragma unroll
                for (int i = 0; i < 8; ++i) { const float x = (i & 1) ? hi16(v[i >> 1]) : lo16(v[i >> 1]); X1[(ch * 8 + i) * LDP + r] = f2bf(x * w); } }
            __syncthreads();
            f32x4 acc[2][4]; zero_acc(acc);
            bgemm128(X2, X1, acc, wm, wn, fr, fq);
            float* Uo = STC + ((size_t)chain * NCH + k) * 16384;
#pragma unroll
            for (int i = 0; i < 2; ++i)
#pragma unroll
                for (int j = 0; j < 4; ++j) *(f32x4*)(Uo + (size_t)(wm * 32 + i * 16 + fr) * 128 + wn * 64 + j * 16 + 4 * fq) = acc[i][j];
            { const int d = tid >> 2, part = tid & 3; float s = 0.f;
              for (int j = 0; j < 32; ++j) s += bf2f(X1[d * LDP + part * 32 + j]);
              s += __shfl_xor(s, 1); s += __shfl_xor(s, 2);
              if (part == 0) STN[((size_t)chain * NCH + k) * 128 + d] = s; }
            if (tid == 0) { float* so = STS + ((size_t)chain * NCH + k) * 4; so[0] = scl[1]; so[1] = amax; }
            __syncthreads();
        }
    }
}
__device__ __forceinline__ void ml_m2(const Params& p, int G) {
    unsigned char* ws = p.ws; int tid_o = threadIdx.x; asm volatile("" : "+v"(tid_o)); const int gt = blockIdx.x * NTHR + tid_o, NGT = G * NTHR;
    float* STC = (float*)(ws + W_STC); float* STN = (float*)(ws + W_STN); float* STS = (float*)(ws + W_STS);
    constexpr int PER = 16384 + 128;
    for (int idx = gt; idx < 16 * PER; idx += NGT) {
        const int chain = idx / PER, e = idx % PER; const int dir = chain & 1;
        float* base = (e < 16384) ? STC + (size_t)chain * NCH * 16384 + e : STN + (size_t)chain * NCH * 128 + (e - 16384);
        const size_t stride = (e < 16384) ? 16384 : 128;
        float* sb = STS + (size_t)chain * NCH * 4;
        float m = 0.f, c = 0.f;
        for (int p0 = 0; p0 < NCH; p0 += 11) {
            float uu[11], bl[11], am[11];
#pragma unroll
            for (int q = 0; q < 11; ++q) { const int k = chunk_at(dir, p0 + q); uu[q] = base[(size_t)k * stride]; bl[q] = sb[k * 4]; am[q] = sb[k * 4 + 1]; }
#pragma unroll
            for (int q = 0; q < 11; ++q) { const int k = chunk_at(dir, p0 + q); base[(size_t)k * stride] = c; if (e == 0) sb[k * 4 + 2] = m;
                const float mx = fmaxf(m, am[q]); c = __expf(m - mx) * c + __expf(am[q] - mx) * uu[q]; m = bl[q] + mx; }
        }
    }
}
__device__ __forceinline__ void ml_m3(const Params& p, int layer, int G, char* ldsc) {
    unsigned char* ws = p.ws; LAS unsigned char* lds = (LAS unsigned char*)ldsc;
    LAS bf16_t* X0 = (LAS bf16_t*)(lds + ML_X0); LAS bf16_t* X1 = (LAS bf16_t*)(lds + ML_X1); LAS bf16_t* X2 = (LAS bf16_t*)(lds + ML_X2); LAS float* vec = (LAS float*)(lds + ML_VEC);
    LAS float* lfA = vec; LAS float* liA = vec + 256; LAS float* bA = vec + 512; LAS float* aA = vec + 640; LAS float* MA = vec + 768; LAS float* denp = vec + 896;
    LAS float* qnA = vec + 1152; LAS float* nin = vec + 1280; LAS float* ssp = vec + 1408;
    const bf16_t* PROJ = (const bf16_t*)(ws + W_PROJ);
    const bf16_t* MLV = PROJ + (size_t)NROWS * SEC_MLV; const bf16_t* MLO = PROJ + (size_t)NROWS * SEC_MLO; const bf16_t* MLZ = PROJ + (size_t)NROWS * SEC_MLZ;
    const bf16_t* CQ = (const bf16_t*)(ws + W_CQ); const bf16_t* CK = (const bf16_t*)(ws + W_CK); const float* GD = (const float*)(ws + W_GD);
    const float* STC = (const float*)(ws + W_STC); const float* STN = (const float*)(ws + W_STN); const float* STS = (const float*)(ws + W_STS);
    bf16_t* MIX = (bf16_t*)(ws + W_XN); const float* mnw = p.in[I_MNORM] + layer * 512;
    for (int u = blockIdx.x; u < 2 * 4 * NCH; u += G) {
        const int k = u % NCH, h = (u / NCH) & 3, b = u / (NCH * 4); const int row0 = b * RB + k * 128;
        if (layer == 1 && k < 2) continue;
        int tid_ = threadIdx.x; asm volatile("" : "+v"(tid_));
        const int tid = tid_, lane = tid & 63, wid = tid >> 6, fr = lane & 15, fq = lane >> 4, wm = wid >> 1, wn = wid & 1;
        __syncthreads();
        for (int c = tid; c < 2048; c += NTHR) { const int r = c >> 4, ch = c & 15; const size_t go = (size_t)(row0 + r) * 512 + h * 128 + ch * 8;
            *(LAS u32x4*)(X0 + r * LDP + ch * 8) = *(const u32x4*)(CQ + go);
            *(LAS u32x4*)(X1 + r * LDP + ch * 8) = *(const u32x4*)(CK + go);
            const u32x4 v = *(const u32x4*)(MLV + go);
#pragma unroll
            for (int i = 0; i < 8; ++i) X2[(ch * 8 + i) * LDP + r] = (bf16_t)((i & 1) ? (v[i >> 1] >> 16) : (v[i >> 1] & 0xffffu)); }
        { const int dir = tid >> 8, which = (tid >> 7) & 1, j = tid & 127; const float val = GD[(size_t)(row0 + j) * 16 + (2 * dir + which) * 4 + h]; (which ? lfA : liA)[dir * 128 + j] = val; }
        __syncthreads();
        f32x4 sacc[2][4]; zero_acc(sacc);
        bgemm128(X0, X1, sacc, wm, wn, fr, fq);
        f32x4 hacc[2][4]; zero_acc(hacc);
        for (int dir = 0; dir < 2; ++dir) {
            const int chain = (b * 4 + h) * 2 + dir;
            gate_scan_b(dir, lfA + dir * 128, liA + dir * 128, bA, aA, tid);
            __syncthreads();
            const float m_in = STS[((size_t)chain * NCH + k) * 4 + 2];
            if (tid < 128) { float pm = -3.0e38f; const int lo = dir ? tid : 0, hi_ = dir ? 127 : tid;
#pragma unroll 1
                for (int s = lo; s <= hi_; ++s) pm = fmaxf(pm, aA[s]);
                MA[tid] = fmaxf(m_in, pm); }
            __syncthreads();
#pragma unroll
            for (int i = 0; i < 2; ++i) { const int t = wm * 32 + i * 16 + fr; const float Mt = MA[t]; float rs = 0.f;
#pragma unroll
                for (int j = 0; j < 4; ++j) { const int s0 = wn * 64 + j * 16 + 4 * fq; const f32x4 av = *(const LAS f32x4*)(aA + s0); float pv[4];
#pragma unroll
                    for (int rg = 0; rg < 4; ++rg) { const int s = s0 + rg; const bool valid = dir ? (s >= t) : (s <= t);
                        const float e = __expf(fminf(av[rg] - Mt, 0.f)); pv[rg] = valid ? sacc[i][j][rg] * e : 0.f; rs += pv[rg]; }
                    u32x2 w; w.x = pk2(pv[0], pv[1]); w.y = pk2(pv[2], pv[3]); *(LAS u32x2*)(X1 + t * LDP + s0) = w; }
                rs += __shfl_xor(rs, 16); rs += __shfl_xor(rs, 32);
                if (fq == 0) denp[wn * 128 + t] = rs; }
            __syncthreads();
            f32x4 nacc[2][4]; zero_acc(nacc);
            bgemm128(X1, X2, nacc, wm, wn, fr, fq);
            __syncthreads();
            { const float* Cg = STC + ((size_t)chain * NCH + k) * 16384;
              for (int c = tid; c < 4096; c += NTHR) { const int e = c >> 5, d4 = (c & 31) * 4; const f32x4 v = *(const f32x4*)(Cg + e * 128 + d4);
                  u32x2 w; w.x = pk2(v.x, v.y); w.y = pk2(v.z, v.w); *(LAS u32x2*)(X1 + e * LDP + d4) = w; }
              if (tid < 128) nin[tid] = STN[((size_t)chain * NCH + k) * 128 + tid]; }
            __syncthreads();
            f32x4 iacc[2][4]; zero_acc(iacc);
            bgemm128(X0, X1, iacc, wm, wn, fr, fq);
            { const int t = tid >> 2, part = tid & 3; float s = 0.f;
              for (int d = 0; d < 32; ++d) s += bf2f(X0[t * LDP + part * 32 + d]) * nin[part * 32 + d];
              s += __shfl_xor(s, 1); s += __shfl_xor(s, 2);
              if (part == 0) qnA[t] = s; }
            __syncthreads();
#pragma unroll
            for (int i = 0; i < 2; ++i) { const int t = wm * 32 + i * 16 + fr; const float Mt = MA[t]; const float wi = __expf(m_in - Mt);
                const float den = denp[t] + denp[128 + t] + wi * qnA[t]; const float fl = __expf(-(bA[t] + Mt)); const float inv = 1.0f / fmaxf(fabsf(den), fl);
#pragma unroll
                for (int j = 0; j < 4; ++j) hacc[i][j] += (nacc[i][j] + iacc[i][j] * wi) * inv; }
            __syncthreads();
        }
#pragma unroll
        for (int i = 0; i < 2; ++i) { const int t = wm * 32 + i * 16 + fr; float ss = 0.f;
#pragma unroll
            for (int j = 0; j < 4; ++j) ss += (hacc[i][j].x * hacc[i][j].x + hacc[i][j].y * hacc[i][j].y) + (hacc[i][j].z * hacc[i][j].z + hacc[i][j].w * hacc[i][j].w);
            ss += __shfl_xor(ss, 16); ss += __shfl_xor(ss, 32);
            if (fq == 0) ssp[wn * 128 + t] = ss; }
        __syncthreads();
#pragma unroll
        for (int i = 0; i < 2; ++i) { const int t = wm * 32 + i * 16 + fr; const float rstd = rsqrtf((ssp[t] + ssp[128 + t]) * (1.0f / 128.0f) + EPSN); const size_t row = (size_t)(row0 + t);
#pragma unroll
            for (int j = 0; j < 4; ++j) { const int e0 = wn * 64 + j * 16 + 4 * fq; const f32x4 nw = *(const f32x4*)(mnw + h * 128 + e0);
                const u32x2 ow = *(const u32x2*)(MLO + row * 512 + h * 128 + e0), zw = *(const u32x2*)(MLZ + row * 512 + h * 128 + e0);
                const float o0 = hacc[i][j].x * rstd * nw.x * sigm(lo16(ow.x)) * silu(lo16(zw.x)), o1 = hacc[i][j].y * rstd * nw.y * sigm(hi16(ow.x)) * silu(hi16(zw.x));
                const float o2 = hacc[i][j].z * rstd * nw.z * sigm(lo16(ow.y)) * silu(lo16(zw.y)), o3 = hacc[i][j].w * rstd * nw.w * sigm(hi16(ow.y)) * silu(hi16(zw.y));
                u32x2 w; w.x = pk2(o0, o1); w.y = pk2(o2, o3); *(u32x2*)(MIX + row * 2048 + 1536 + h * 128 + e0) = w; } }
    }
}
#ifndef PHMASK
#define PHMASK 0xFFFF
#endif
__global__ void __launch_bounds__(NTHR, 2) mega_fwd(Params p) {
    extern __shared__ __attribute__((aligned(16))) unsigned char lds_raw[];
    cg::grid_group grid = cg::this_grid();
    char* lds = (char*)lds_raw;
    const int G = gridDim.x;
    unsigned char* ws = p.ws;
    bf16_t* XN = (bf16_t*)(ws + W_XN); bf16_t* PROJ = (bf16_t*)(ws + W_PROJ);


#if (PHMASK>>0)&1
p0_prologue(p, lds, G);
#endif

    grid.sync();

#if (PHMASK>>1)&1
p0b_ada(p, G);
#endif

    grid.sync();
    for (int layer = 0; layer < 2; ++layer) {
        const int lat_only = (layer == 1) ? 1 : 0;

#if (PHMASK>>2)&1
p1_xn(p, layer, G);
#endif

        grid.sync();

#if (PHMASK>>3)&1
{
            pg8::Gemm g{XN, (const bf16_t*)(ws + W_WIN + layer * SZ_WIN), NROWS, NPROJ, DM};
            pg8::StaticOrder S; S.init(NROWS / 256, NPROJ / 256, G, (int)blockIdx.x, 0);
            pg8::EpiProj E{PROJ, (float*)(ws + W_GRAW)};
            pg8::gemm_phase<pg8::EpiProj, pg8::StaticOrder, true, true>((PG8_LAS unsigned char*)lds_raw, g, S, E);
        }
#endif

        grid.sync();

#if (PHMASK>>4)&1
p3_post(p, layer, G);
#endif

        grid.sync();

#if (PHMASK>>5)&1
p4_attn(p, layer, G, lds);
#endif

        __syncthreads();

#if (PHMASK>>6)&1
ml_m1(p, layer, G, lds);
#endif

        __syncthreads();

#if (PHMASK>>7)&1
s5_pass1(p, layer, G, lds);
#endif

        grid.sync();

#if (PHMASK>>8)&1
s5_carry(p, layer, G);
#endif


#if (PHMASK>>9)&1
ml_m2(p, G);
#endif

        grid.sync();

#if (PHMASK>>10)&1
s5_pass2(p, layer, G, lds);
#endif

        __syncthreads();

#if (PHMASK>>11)&1
ml_m3(p, layer, G, lds);
#endif

        grid.sync();

#if (PHMASK>>12)&1
{
            pg8::Gemm g{PROJ + (size_t)NROWS * SEC_S5U, (const bf16_t*)(ws + W_WGLU + layer * SZ_WGLU), NROWS, 512, 512};
            pg8::StaticOrder S; S.init(lat_only ? 64 : 66, 2, G, (int)blockIdx.x, lat_only);
            pg8::EpiGlu E{PROJ + (size_t)NROWS * SEC_S5U, PROJ + (size_t)NROWS * SEC_S5Z, XN};
            pg8::gemm_phase<pg8::EpiGlu, pg8::StaticOrder, true, true>((PG8_LAS unsigned char*)lds_raw, g, S, E);
        }
#endif

        grid.sync();

#if (PHMASK>>13)&1
{
            pg8::Gemm g{XN, (const bf16_t*)(ws + W_WOUT + layer * SZ_WOUT), NROWS, DM, DM};
            pg8::StaticOrder S; S.init(lat_only ? 64 : 66, DM / 256, G, (int)blockIdx.x, lat_only);
            pg8::EpiOut E{layer == 0 ? p.in[I_X] : (const float*)p.out, layer == 0 ? p.in[I_CTX] : (const float*)(ws + W_HCTX), p.out, (float*)(ws + W_HCTX),
                          (const float*)(ws + W_ADA) + layer * 3 * 6144};
            pg8::gemm_phase<pg8::EpiOut, pg8::StaticOrder, true, true>((PG8_LAS unsigned char*)lds_raw, g, S, E);
        }
#endif

        grid.sync();
    }

#if (PHMASK>>14)&1
p_final(p, G);
#endif

}

extern "C" void kernel_launch(void* const* d_in, const int* in_sizes, int n_in, void* d_out, int out_size, void* d_ws, size_t ws_size, hipStream_t stream) {
    static int grid = 0;
    if (grid == 0) {
        if (n_in != 25 || in_sizes[0] != NBATCH * SEQ * DM || out_size != NBATCH * SEQ * DM || ws_size < W_END) {
            fprintf(stderr, "kernel_launch: shape mismatch (n_in %d, in0 %d, out %d, ws %zu, need ws >= %zu)\n", n_in, n_in > 0 ? in_sizes[0] : -1, out_size, ws_size, (size_t)W_END); grid = -1; return; }
        int dev = 0, cus = 0, per_cu = 0;
        if (hipGetDevice(&dev) != hipSuccess || hipDeviceGetAttribute(&cus, hipDeviceAttributeMultiprocessorCount, dev) != hipSuccess) { grid = -1; return; }
        if (hipFuncSetAttribute((const void*)mega_fwd, hipFuncAttributeMaxDynamicSharedMemorySize, LDS_BYTES) != hipSuccess) { fprintf(stderr, "kernel_launch: hipFuncSetAttribute failed\n"); grid = -1; return; }
        if (hipOccupancyMaxActiveBlocksPerMultiprocessor(&per_cu, (const void*)mega_fwd, NTHR, LDS_BYTES) != hipSuccess || per_cu < 1) { fprintf(stderr, "kernel_launch: occupancy query says %d\n", per_cu); per_cu = 1; }
        (void)hipGetLastError();
        grid = cus;
    }
    if (grid < 0) return;
    Params p{};
    for (int i = 0; i < 25; ++i) p.in[i] = (const float*)d_in[i];
    p.out = (float*)d_out; p.ws = (unsigned char*)d_ws;
    void* args[] = {&p};
    const hipError_t e = hipLaunchCooperativeKernel((const void*)mega_fwd, dim3(grid), dim3(NTHR), args, LDS_BYTES, stream);
    if (e != hipSuccess) fprintf(stderr, "kernel_launch: cooperative launch failed: %s (grid %d)\n", hipGetErrorString(e), grid);
}
```

```cpp
#include <hip/hip_runtime.h>
#include <hip/hip_cooperative_groups.h>
#include <hip/hip_bf16.h>
#include <cstdio>
#include <cstdint>
#include <cmath>
namespace cg = cooperative_groups;

constexpr int DM = 2048, NBATCH = 2, SEQ = 8192, CTX = 256, RB = SEQ + CTX  , NROWS = NBATCH * RB  ;
constexpr int NCOL_IN = 6160, NPROJ = 6400;
constexpr int NCH = RB / 128;
constexpr float EPSN = 1e-6f;
namespace pg8 {
#define PG8_LAS __attribute__((address_space(3)))
typedef unsigned short bf16_t;
typedef short bf16x8 __attribute__((ext_vector_type(8)));
typedef float f32x4 __attribute__((ext_vector_type(4)));
typedef unsigned u32x4 __attribute__((ext_vector_type(4)));
constexpr int BM = 256, BK = 64, HALF = 128, HTB = HALF * BK * 2  , STAGE_BYTES = 8 * HTB, NXCD = 8, WGM = 8;

__host__ __device__ __forceinline__ int lds_byte(int r, int c) { const int st = (r >> 4) * 2 + (c >> 5), rr = r & 15, cc = c & 31, ob = rr * 64 + cc * 2; return st * 1024 + (ob ^ (((ob >> 9) & 1) << 5)); }
__host__ __device__ __forceinline__ void stage_rc(int b, int& R, int& C) { const int st = b / 1024, sb = b % 1024, swz = sb ^ (((sb >> 9) & 1) << 5); R = (st >> 1) * 16 + swz / 64; C = (st & 1) * 32 + (swz % 64) / 2; }
__host__ __device__ __forceinline__ int perm32(int rho) { const int n = rho >> 4, i = rho & 15; return 8 * (i >> 2) + 4 * n + (i & 3); }

struct Unit { int pm, pn; };
struct Gemm { const bf16_t* A; const bf16_t* Bt; int M, N, K; };

struct StaticOrder {
    int nM, nN, nwg, G, c, lat_only;
    __host__ __device__ void init(int nM_, int nN_, int G_, int c_, int lat_only_) { nM = nM_; nN = nN_; nwg = nM * nN; G = G_; c = c_; lat_only = lat_only_; }
    __host__ __device__ bool next(int i, Unit& u) const {
        const long L = (long)i * G + c; if (L >= nwg) return false;
        int wgid = (int)L; { const int q = nwg / NXCD, r = nwg % NXCD, xcd = wgid % NXCD, off = wgid / NXCD; wgid = (xcd < r ? xcd * (q + 1) : r * (q + 1) + (xcd - r) * q) + off; }
        const int nig = WGM * nN, gid = wgid / nig, fm = gid * WGM, gsz = (nM - fm) < WGM ? (nM - fm) : WGM;
        int pm = fm + ((wgid % nig) % gsz); u.pn = (wgid % nig) / gsz;
        if (lat_only) pm = pm + 1 + (pm >= 32 ? 1 : 0);
        u.pm = pm; return true;
    }
    __device__ __forceinline__ void a_ready(const Unit&) const {}
    __device__ __forceinline__ void done(const Unit&) const {}
};
__device__ __forceinline__ unsigned cvt_pk_bf16(float lo, float hi) { unsigned r; asm volatile("v_cvt_pk_bf16_f32 %0, %1, %2" : "=v"(r) : "v"(lo), "v"(hi)); return r; }
typedef float f32x2 __attribute__((ext_vector_type(2)));
__device__ __forceinline__ float bf2f(unsigned short b) { return __uint_as_float(((unsigned)b) << 16); }
__device__ __forceinline__ float sigmoidf_(float x) { return 1.0f / (1.0f + __expf(-x)); }
__device__ __forceinline__ float siluf_(float x) { return x / (1.0f + __expf(-x)); }
struct EpiProj {
    static constexpr bool PERM = true, AFTER_DRAIN = false;
    bf16_t* proj; float* graw;
    __device__ __forceinline__ void operator()(const f32x4 (&acc)[2][2][4][2], const Unit& u, int wr, int wc, int fr, int fq) const {
        const int row0 = u.pm * BM + wr * 64 + fr; const int cst = u.pn * BM;
        if (cst >= 6144) {
            if (wc == 0 && fq < 2) {
#pragma unroll
                for (int ai = 0; ai < 2; ++ai)
#pragma unroll
                    for (int m = 0; m < 4; ++m) { float* gp = graw + (size_t)(row0 + ai * HALF + m * 16) * 16 + 8 * fq; *(f32x4*)gp = acc[ai][0][m][0]; *(f32x4*)(gp + 4) = acc[ai][0][m][1]; }
            }
            return;
        }
        int ss, ld;
        if (cst < 512) { ss = 0; ld = 512; } else if (cst < 1024) { ss = 512; ld = 512; } else if (cst < 2048) { ss = 1024; ld = 1024; } else if (cst < 2304) { ss = 2048; ld = 256; }
        else if (cst < 2560) { ss = 2304; ld = 256; } else if (cst < 3584) { ss = 2560; ld = 1024; } else { ss = 3584 + ((cst - 3584) >> 9) * 512; ld = 512; }
        bf16_t* base = proj + (size_t)NROWS * ss; const int col0 = cst - ss + wc * 32 + 8 * fq;
#pragma unroll
        for (int ai = 0; ai < 2; ++ai)
#pragma unroll
            for (int m = 0; m < 4; ++m) { bf16_t* rowp = base + (size_t)(row0 + ai * HALF + m * 16) * ld + col0;
#pragma unroll
                for (int bj = 0; bj < 2; ++bj) { const f32x4 v0 = acc[ai][bj][m][0], v1 = acc[ai][bj][m][1];
                    u32x4 w; w.x = cvt_pk_bf16(v0[0], v0[1]); w.y = cvt_pk_bf16(v0[2], v0[3]); w.z = cvt_pk_bf16(v1[0], v1[1]); w.w = cvt_pk_bf16(v1[2], v1[3]);
                    *(u32x4*)(rowp + bj * HALF) = w; } }
    }
};
struct EpiGlu {
    static constexpr bool PERM = true, AFTER_DRAIN = false;
    const bf16_t* G; const bf16_t* Z; bf16_t* MIX;
    __device__ __forceinline__ void operator()(const f32x4 (&acc)[2][2][4][2], const Unit& u, int wr, int wc, int fr, int fq) const {
        const int row0 = u.pm * BM + wr * 64 + fr; const int col0 = u.pn * BM + wc * 32 + 8 * fq;
#pragma unroll
        for (int ai = 0; ai < 2; ++ai)
#pragma unroll
            for (int m = 0; m < 4; ++m) { const size_t row = (size_t)(row0 + ai * HALF + m * 16);
#pragma unroll
                for (int bj = 0; bj < 2; ++bj) { const int c = col0 + bj * HALF;
                    const u32x4 gw = *(const u32x4*)(G + row * 512 + c), zw = *(const u32x4*)(Z + row * 512 + c);
                    const f32x4 v0 = acc[ai][bj][m][0], v1 = acc[ai][bj][m][1];
                    float o[8];
#pragma unroll
                    for (int e = 0; e < 8; ++e) { const unsigned gq = gw[e >> 1], zq = zw[e >> 1];
                        const float g = (e & 1) ? __uint_as_float(gq & 0xffff0000u) : __uint_as_float(gq << 16);
                        const float z = (e & 1) ? __uint_as_float(zq & 0xffff0000u) : __uint_as_float(zq << 16);
                        const float a = e < 4 ? v0[e & 3] : v1[e & 3];
                        o[e] = g * sigmoidf_(a) * siluf_(z); }
                    u32x4 w; w.x = cvt_pk_bf16(o[0], o[1]); w.y = cvt_pk_bf16(o[2], o[3]); w.z = cvt_pk_bf16(o[4], o[5]); w.w = cvt_pk_bf16(o[6], o[7]);
                    *(u32x4*)(MIX + row * 2048 + c) = w; } }
    }
};
struct EpiOut {
    static constexpr bool PERM = true, AFTER_DRAIN = false;
    const float* lat_src; const float* ctx_src; float* lat_dst; float* ctx_dst; const float* ada;
    __device__ __forceinline__ void operator()(const f32x4 (&acc)[2][2][4][2], const Unit& u, int wr, int wc, int fr, int fq) const {
        const int b = u.pm / 33, j = u.pm % 33; const bool isc = (j == 0);
        const size_t roff = isc ? (size_t)(b * CTX) * DM : (size_t)(b * SEQ + (j - 1) * 256) * DM;
        const float* src = (isc ? ctx_src : lat_src) + roff; float* dst = (isc ? ctx_dst : lat_dst) + roff;
        const float* gate = ada + (isc ? 2 : b) * 6144 + 4096;
        const int col0 = u.pn * BM + wc * 32 + 8 * fq;
#pragma unroll
        for (int bj = 0; bj < 2; ++bj) { const int c = col0 + bj * HALF; const f32x4 g0 = *(const f32x4*)(gate + c), g1 = *(const f32x4*)(gate + c + 4);
#pragma unroll
            for (int ai = 0; ai < 2; ++ai) {
                f32x4 h0[4], h1[4];
#pragma unroll
                for (int m = 0; m < 4; ++m) { const size_t off = (size_t)(ai * HALF + wr * 64 + m * 16 + fr) * DM + c; h0[m] = *(const f32x4*)(src + off); h1[m] = *(const f32x4*)(src + off + 4); }
#pragma unroll
                for (int m = 0; m < 4; ++m) { const size_t off = (size_t)(ai * HALF + wr * 64 + m * 16 + fr) * DM + c;
                    *(f32x4*)(dst + off) = h0[m] + g0 * acc[ai][bj][m][0]; *(f32x4*)(dst + off + 4) = h1[m] + g1 * acc[ai][bj][m][1]; }
            } }
    }
};

struct EpiDelta {
    static constexpr bool PERM = true, AFTER_DRAIN = false;
    bf16_t* delta; const float* ada; int ld;
    __device__ __forceinline__ void operator()(const f32x4 (&acc)[2][2][4][2], const Unit& u, int wr, int wc, int fr, int fq) const {
        const int b = u.pm / 33, j = u.pm % 33;
        bf16_t* dst = delta + (size_t)(b * SEQ + (j - 1) * 256) * ld; const float* gate = ada + b * 6144 + 4096;
        const int col0 = u.pn * BM + wc * 32 + 8 * fq;
#pragma unroll
        for (int bj = 0; bj < 2; ++bj) { const int c = col0 + bj * HALF; const f32x4 g0 = *(const f32x4*)(gate + c), g1 = *(const f32x4*)(gate + c + 4);
#pragma unroll
            for (int ai = 0; ai < 2; ++ai)
#pragma unroll
                for (int m = 0; m < 4; ++m) { const f32x4 v0 = g0 * acc[ai][bj][m][0], v1 = g1 * acc[ai][bj][m][1];
                    u32x4 w; w.x = cvt_pk_bf16(v0[0], v0[1]); w.y = cvt_pk_bf16(v0[2], v0[3]); w.z = cvt_pk_bf16(v1[0], v1[1]); w.w = cvt_pk_bf16(v1[2], v1[3]);
                    *(u32x4*)(dst + (size_t)(ai * HALF + wr * 64 + m * 16 + fr) * ld + c) = w; } }
    }
};
template <class Epi, class Sched, bool ALIGN_EPI = false, bool SP2 = false>
__device__ __forceinline__ void gemm_phase(PG8_LAS unsigned char* lds, const Gemm g, const Sched& S, const Epi& E) {
    int tid_ = threadIdx.x; asm volatile("" : "+v"(tid_));
    const int tid = tid_, wid = __builtin_amdgcn_readfirstlane(tid >> 6), lane = tid & 63, wr = wid >> 2, wc = wid & 3, fr = lane & 15, fq = lane >> 4;
    const int K = g.K, nt = K / BK;
    unsigned voffA[2], voffB[2];
#pragma unroll
    for (int i = 0; i < 2; ++i) { int R, C; stage_rc(tid * 16 + i * 8192, R, C); const int Rb = Epi::PERM ? ((R & ~31) + perm32(R & 31)) : R;
        voffA[i] = (unsigned)(R * K + C) * 2u; voffB[i] = (unsigned)(Rb * K + C) * 2u; }
    const size_t kstep = (size_t)(BK * 2);
    const size_t hstep = (size_t)HALF * K * 2;
    const size_t tstep = 2 * hstep;
    const unsigned ldsw = (unsigned)wid * 1024u;
    const int aoff = lds_byte(wr * 64 + fr, fq * 8), boff = lds_byte(wc * 32 + fr, fq * 8);
#define PG8_SA(b, h) (((b) * 2 + (h)) * HTB)
#define PG8_SB(b, h) ((4 + (b) * 2 + (h)) * HTB)
#define PG8_STAGE(bufoff, gbase, voff) do { _Pragma("unroll") for (int _i = 0; _i < 2; ++_i) \
        __builtin_amdgcn_global_load_lds((const unsigned*)((const char*)(gbase) + (voff)[_i]), (PG8_LAS unsigned*)(lds + (bufoff) + ldsw + _i * 8192), 16, 0, 0); } while (0)
#define PG8_LDA(dst, b, h) do { _Pragma("unroll") for (int m = 0; m < 4; ++m) _Pragma("unroll") for (int k = 0; k < 2; ++k) dst[m][k] = *(const PG8_LAS bf16x8*)(lds + PG8_SA(b, h) + aoff + m * 2048 + k * 1024); } while (0)
#define PG8_LDB(dst, b, h) do { _Pragma("unroll") for (int n = 0; n < 2; ++n) _Pragma("unroll") for (int k = 0; k < 2; ++k) dst[n][k] = *(const PG8_LAS bf16x8*)(lds + PG8_SB(b, h) + boff + n * 2048 + k * 1024); } while (0)
#define PG8_MMA(ai, bj, At, Bt) do { __builtin_amdgcn_s_setprio(1); _Pragma("unroll") for (int m = 0; m < 4; ++m) _Pragma("unroll") for (int n = 0; n < 2; ++n) _Pragma("unroll") for (int k = 0; k < 2; ++k) \
        acc[ai][bj][m][n] = __builtin_amdgcn_mfma_f32_16x16x32_bf16(Bt[n][k], At[m][k], acc[ai][bj][m][n], 0, 0, 0); __builtin_amdgcn_s_setprio(0); } while (0)
#define PG8_WAIT_V(n) asm volatile("s_waitcnt vmcnt(" #n ")" ::: "memory")
#define PG8_WAIT_L(n) asm volatile("s_waitcnt lgkmcnt(" #n ")" ::: "memory")
#define PG8_BAR __builtin_amdgcn_s_barrier()
#define PG8_SCHED __builtin_amdgcn_sched_barrier(0)
    Unit cur, nxt; int ui = 0;
    if (!S.next(0, cur)) return;
    f32x4 acc[2][2][4][2];
#pragma unroll
    for (int a = 0; a < 2; ++a)
#pragma unroll
        for (int b = 0; b < 2; ++b)
#pragma unroll
            for (int m = 0; m < 4; ++m)
#pragma unroll
                for (int n = 0; n < 2; ++n) acc[a][b][m][n] = (f32x4){0.f, 0.f, 0.f, 0.f};
    bf16x8 At[4][2], B0[2][2], B1[2][2];
    const char* cA = (const char*)g.A + (size_t)cur.pm * tstep; const char* cB = (const char*)g.Bt + (size_t)cur.pn * tstep;
    S.a_ready(cur);
    if constexpr (SP2) {
        PG8_STAGE(PG8_SB(0, 0), cB, voffB); PG8_STAGE(PG8_SB(0, 1), cB + hstep, voffB); PG8_STAGE(PG8_SA(0, 0), cA, voffA); PG8_STAGE(PG8_SA(0, 1), cA + hstep, voffA);
        if (wr == 1) PG8_BAR;
        PG8_WAIT_V(2); PG8_BAR;
        PG8_STAGE(PG8_SB(1, 0), cB + kstep, voffB); PG8_STAGE(PG8_SA(1, 0), cA + kstep, voffA); PG8_STAGE(PG8_SB(1, 1), cB + hstep + kstep, voffB);
        PG8_WAIT_V(6); PG8_BAR;
    } else {
        PG8_STAGE(PG8_SB(0, 0), cB, voffB); PG8_STAGE(PG8_SA(0, 0), cA, voffA); PG8_STAGE(PG8_SB(0, 1), cB + hstep, voffB); PG8_STAGE(PG8_SA(0, 1), cA + hstep, voffA);
        if (wr == 1) PG8_BAR;
        PG8_WAIT_V(4); PG8_BAR;
        PG8_STAGE(PG8_SB(1, 0), cB + kstep, voffB); PG8_STAGE(PG8_SA(1, 0), cA + kstep, voffA); PG8_STAGE(PG8_SB(1, 1), cB + hstep + kstep, voffB);
        PG8_WAIT_V(6); PG8_BAR;
    }
    for (;;) {
        const bool has_next = S.next(ui + 1, nxt);
        const char* nA = has_next ? (const char*)g.A + (size_t)nxt.pm * tstep : cA; const char* nB = has_next ? (const char*)g.Bt + (size_t)nxt.pn * tstep : cB;
        for (int t = 0; t < nt; t += 2) {
            const bool last = (t == nt - 2);
            const char* a1 = cA + (size_t)(t + 1) * kstep;
            const char* a2 = last ? nA : cA + (size_t)(t + 2) * kstep; const char* b2 = last ? nB : cB + (size_t)(t + 2) * kstep;
            const char* a3 = a2 + kstep; const char* b3 = b2 + kstep;
            if (last && has_next) S.a_ready(nxt);
            if constexpr (SP2) {
            PG8_LDB(B0, 0, 0); PG8_LDB(B1, 0, 1); PG8_SCHED; PG8_LDA(At, 0, 0); PG8_STAGE(PG8_SA(1, 1), a1 + hstep, voffA);
            PG8_WAIT_V(8); PG8_WAIT_L(0); PG8_BAR; PG8_MMA(0, 0, At, B0); PG8_MMA(0, 1, At, B1); PG8_BAR; PG8_SCHED;
            PG8_LDA(At, 0, 1); PG8_STAGE(PG8_SB(0, 0), b2, voffB); PG8_STAGE(PG8_SB(0, 1), b2 + hstep, voffB); PG8_STAGE(PG8_SA(0, 0), a2, voffA);
            PG8_WAIT_V(8); PG8_WAIT_L(0); PG8_BAR; PG8_MMA(1, 0, At, B0); PG8_MMA(1, 1, At, B1); PG8_BAR; PG8_SCHED;
            PG8_LDB(B0, 1, 0); PG8_LDB(B1, 1, 1); PG8_SCHED; PG8_LDA(At, 1, 0); PG8_STAGE(PG8_SA(0, 1), a2 + hstep, voffA);
            PG8_WAIT_V(8); PG8_WAIT_L(0); PG8_BAR; PG8_MMA(0, 0, At, B0); PG8_MMA(0, 1, At, B1); PG8_BAR; PG8_SCHED;
            PG8_LDA(At, 1, 1); PG8_STAGE(PG8_SB(1, 0), b3, voffB); PG8_STAGE(PG8_SB(1, 1), b3 + hstep, voffB); PG8_STAGE(PG8_SA(1, 0), a3, voffA);
            PG8_WAIT_V(8); PG8_WAIT_L(0); PG8_BAR; PG8_MMA(1, 0, At, B0); PG8_MMA(1, 1, At, B1); PG8_BAR; PG8_SCHED;
            } else {
            PG8_LDB(B0, 0, 0); PG8_SCHED; PG8_LDA(At, 0, 0); PG8_STAGE(PG8_SA(1, 1), a1 + hstep, voffA);
            PG8_WAIT_L(8); PG8_BAR; PG8_WAIT_L(0); PG8_MMA(0, 0, At, B0); PG8_BAR; PG8_SCHED;
            PG8_LDB(B1, 0, 1); PG8_STAGE(PG8_SB(0, 0), b2, voffB);
            PG8_BAR; PG8_WAIT_L(0); PG8_MMA(0, 1, At, B1); PG8_BAR;
            PG8_LDA(At, 0, 1); PG8_STAGE(PG8_SA(0, 0), a2, voffA);
            PG8_BAR; PG8_WAIT_L(0); PG8_MMA(1, 0, At, B0); PG8_BAR; PG8_SCHED;
            PG8_STAGE(PG8_SB(0, 1), b2 + hstep, voffB);
            PG8_WAIT_V(6); PG8_BAR; PG8_MMA(1, 1, At, B1); PG8_BAR;
            PG8_LDB(B0, 1, 0); PG8_SCHED; PG8_LDA(At, 1, 0); PG8_STAGE(PG8_SA(0, 1), a2 + hstep, voffA);
            PG8_WAIT_L(8); PG8_BAR; PG8_WAIT_L(0); PG8_MMA(0, 0, At, B0); PG8_BAR; PG8_SCHED;
            PG8_LDB(B1, 1, 1); PG8_STAGE(PG8_SB(1, 0), b3, voffB);
            PG8_BAR; PG8_WAIT_L(0); PG8_MMA(0, 1, At, B1); PG8_BAR;
            PG8_LDA(At, 1, 1); PG8_STAGE(PG8_SA(1, 0), a3, voffA);
            PG8_BAR; PG8_WAIT_L(0); PG8_MMA(1, 0, At, B0); PG8_BAR; PG8_SCHED;
            PG8_STAGE(PG8_SB(1, 1), b3 + hstep, voffB);
            PG8_WAIT_V(6); PG8_BAR; PG8_MMA(1, 1, At, B1); PG8_BAR;
            }
        }
        if constexpr (ALIGN_EPI) { if (wr == 0) PG8_BAR; }
        if constexpr (!Epi::AFTER_DRAIN) { E(acc, cur, wr, wc, fr, fq); S.done(cur); }
        if (!has_next) break;
#pragma unroll
        for (int a = 0; a < 2; ++a)
#pragma unroll
            for (int b = 0; b < 2; ++b)
#pragma unroll
                for (int m = 0; m < 4; ++m)
#pragma unroll
                    for (int n = 0; n < 2; ++n) acc[a][b][m][n] = (f32x4){0.f, 0.f, 0.f, 0.f};
        cur = nxt; cA = nA; cB = nB; ++ui;
        if constexpr (ALIGN_EPI) { if (wr == 1) PG8_BAR; }
    }
    PG8_WAIT_V(0);
    if constexpr (!ALIGN_EPI) { if (wr == 0) PG8_BAR; }
    PG8_BAR;
    if constexpr (Epi::AFTER_DRAIN) { E.fused(acc, cur, wr, wc, fr, fq, lds, wid, lane); S.done(cur); }
#undef PG8_SA
#undef PG8_SB
#undef PG8_STAGE
#undef PG8_LDA
#undef PG8_LDB
#undef PG8_MMA
#undef PG8_WAIT_V
#undef PG8_WAIT_L
#undef PG8_BAR
#undef PG8_SCHED
}
}
namespace attn {
using bf16 = unsigned short;
constexpr int D = 128, NW = 8, QBLK = 32, KVBLK = 64;
constexpr float SCALE = 0.088388347648318440f;
constexpr float THR = 8.f;
constexpr int SDEPTH = 1;
constexpr int LDQ = 1024, LDK = 256, LDZ = 1024, LDM = 2048;
constexpr int NSLOT = 3;
constexpr size_t SHM_V = KVBLK * D * 2, SHM_K = KVBLK * D * 2, SHM_ATTN = NSLOT * SHM_V + NSLOT * SHM_K + NW * 64 * 4;
using bf16x8 = __attribute__((ext_vector_type(8))) short;
using s16x4  = __attribute__((ext_vector_type(4))) short;
using f32x16 = __attribute__((ext_vector_type(16))) float;
using f32x8  = __attribute__((ext_vector_type(8))) float;
using u32x4  = __attribute__((ext_vector_type(4))) unsigned;
#define KSWZ(row, colB) ((row) * 256 + ((colB) ^ (((row) & 7) << 4)))
#define SBAR() __builtin_amdgcn_sched_barrier(0)
__device__ __forceinline__ int crow(int r, int hi) { return (r & 3) + 8 * (r >> 2) + 4 * hi; }
__device__ __forceinline__ unsigned cvtpk(float lo, float hi) {
  unsigned r; asm volatile("v_cvt_pk_bf16_f32 %0, %1, %2" : "=v"(r) : "v"(lo), "v"(hi)); return r;
}

__device__ __forceinline__ void partialSM(f32x16& p0) {
  for (int r = 0; r < 16; ++r) p0[r] = __builtin_amdgcn_exp2f(p0[r]);
}
__device__ __forceinline__ void finishSM(f32x16& p0, f32x16& p1, float& l_reg, bf16x8& pa0, bf16x8& pa1, bf16x8& pa2, bf16x8& pa3) {
  for (int r = 0; r < 16; ++r) p1[r] = __builtin_amdgcn_exp2f(p1[r]);
  typedef float f32x2a __attribute__((ext_vector_type(2)));
  f32x2a a2 = {0.f, 0.f}, b2 = {0.f, 0.f};
#pragma unroll
  for (int r = 0; r < 16; r += 2) { a2 = a2 + (f32x2a){p0[r], p0[r + 1]}; b2 = b2 + (f32x2a){p1[r], p1[r + 1]}; }
  a2 = a2 + b2; float ps = a2.x + a2.y;
  { auto rr = __builtin_amdgcn_permlane32_swap(__float_as_uint(ps), __float_as_uint(ps), false, false);
    ps = __uint_as_float(rr[0]) + __uint_as_float(rr[1]); }
  l_reg += ps;
#define PK4(P, BASE, OUT) do { unsigned a0 = cvtpk(P[BASE + 0], P[BASE + 1]), a1 = cvtpk(P[BASE + 2], P[BASE + 3]);   \
    unsigned b0 = cvtpk(P[BASE + 4], P[BASE + 5]), b1 = cvtpk(P[BASE + 6], P[BASE + 7]);                              \
    auto r0 = __builtin_amdgcn_permlane32_swap(a0, b0, false, false); auto r1 = __builtin_amdgcn_permlane32_swap(a1, b1, false, false); \
    u32x4 w = {r0[0], r1[0], r0[1], r1[1]}; OUT = *reinterpret_cast<bf16x8*>(&w); } while (0)
  PK4(p0, 0, pa0); PK4(p0, 8, pa1); PK4(p1, 0, pa2); PK4(p1, 8, pa3);
#undef PK4
}
__device__ __forceinline__ void qkt(f32x16& p0, f32x16& p1, const bf16* Ks, const bf16x8* qr, const f32x16& negm, int r32, int hi) {
  for (int d0 = 0; d0 < 8; ++d0) { int cb = (d0 * 16 + hi * 8) * 2;
    bf16x8 b0 = *reinterpret_cast<const bf16x8*>((const char*)Ks + KSWZ(r32, cb));
    bf16x8 b1 = *reinterpret_cast<const bf16x8*>((const char*)Ks + KSWZ(32 + r32, cb));
    if (d0 == 0) { p0 = __builtin_amdgcn_mfma_f32_32x32x16_bf16(b0, qr[0], negm, 0, 0, 0); p1 = __builtin_amdgcn_mfma_f32_32x32x16_bf16(b1, qr[0], negm, 0, 0, 0); }
    else { p0 = __builtin_amdgcn_mfma_f32_32x32x16_bf16(b0, qr[d0], p0, 0, 0, 0); p1 = __builtin_amdgcn_mfma_f32_32x32x16_bf16(b1, qr[d0], p1, 0, 0, 0); } }
}
__device__ __forceinline__ int v_st(int k, int c) { const int kk = (k & ~0xC) | ((k & 4) << 1) | ((k & 8) >> 1); return ((kk >> 3) * 4 + (c >> 5)) * 512 + ((kk & 7) * 32 + (c & 31)) * 2; }
__device__ __forceinline__ int v_rd_base(int lane) { return ((lane & 3) << 3) | (((lane >> 2) & 3) << 6) | (((lane >> 4) & 1) << 5) | (((lane >> 5) & 1) << 8); }
constexpr int v_rd_off(int d0, int ks, int half) { return d0 * 512 + ks * 4096 + half * 2048; }
template <int OFF> __device__ __forceinline__ s16x4 tr_read(int vb) {
  s16x4 r; asm volatile("ds_read_b64_tr_b16 %0, %1 offset:%2" : "=&v"(r) : "v"(vb), "i"(OFF) : "memory"); return r;
}
template <int D0> __device__ __forceinline__ void pv_one(f32x16& od, int vb, bf16x8 pa0, bf16x8 pa1, bf16x8 pa2, bf16x8 pa3) {
  const s16x4 l0 = tr_read<v_rd_off(D0, 0, 0)>(vb), h0 = tr_read<v_rd_off(D0, 0, 1)>(vb), l1 = tr_read<v_rd_off(D0, 1, 0)>(vb), h1 = tr_read<v_rd_off(D0, 1, 1)>(vb);
  const s16x4 l2 = tr_read<v_rd_off(D0, 2, 0)>(vb), h2 = tr_read<v_rd_off(D0, 2, 1)>(vb), l3 = tr_read<v_rd_off(D0, 3, 0)>(vb), h3 = tr_read<v_rd_off(D0, 3, 1)>(vb);
  asm volatile("s_waitcnt lgkmcnt(0)" ::: "memory"); SBAR();
#define PK(L, H) (bf16x8){L[0], L[1], L[2], L[3], H[0], H[1], H[2], H[3]}
  od = __builtin_amdgcn_mfma_f32_32x32x16_bf16(pa0, PK(l0, h0), od, 0, 0, 0);
  od = __builtin_amdgcn_mfma_f32_32x32x16_bf16(pa1, PK(l1, h1), od, 0, 0, 0);
  od = __builtin_amdgcn_mfma_f32_32x32x16_bf16(pa2, PK(l2, h2), od, 0, 0, 0);
  od = __builtin_amdgcn_mfma_f32_32x32x16_bf16(pa3, PK(l3, h3), od, 0, 0, 0);
#undef PK
}
__device__ __forceinline__ void pv_d0(f32x16* o, int vb, bf16x8 pa0, bf16x8 pa1, bf16x8 pa2, bf16x8 pa3) {
  pv_one<0>(o[0], vb, pa0, pa1, pa2, pa3); pv_one<1>(o[1], vb, pa0, pa1, pa2, pa3); pv_one<2>(o[2], vb, pa0, pa1, pa2, pa3); pv_one<3>(o[3], vb, pa0, pa1, pa2, pa3);
}
__device__ __forceinline__ bf16x8 ld8(const bf16* p) { return *reinterpret_cast<const bf16x8*>(p); }
template <bool LATE>
__device__ __forceinline__ void attn_dense_half(const bf16* __restrict__ Qb, const bf16* __restrict__ Kh, const bf16* __restrict__ Vh,
                                                const bf16* __restrict__ Zb, bf16* __restrict__ Mb, int seq, float negmv, char* lds) {
  int tid_ = threadIdx.x; asm volatile("" : "+v"(tid_));
  const int tid = tid_, wid = tid >> 6, lane = tid & 63, r32 = lane & 31, hi = lane >> 5;
  bf16* V_lds = (bf16*)lds; bf16* K_lds = (bf16*)(lds + NSLOT * SHM_V);
  float* ws = (float*)(lds + NSLOT * SHM_V + NSLOT * SHM_K) + wid * 64; float* li_l = ws;
  float l_reg = 0; f32x16 o[4] = {}; bf16x8 qr[8];
  f32x16 negm; for (int r = 0; r < 16; ++r) negm[r] = negmv; asm volatile("" : "+v"(negm));
  const bf16* Qw = Qb + (long)(wid * QBLK + r32) * LDQ + hi * 8;
#pragma unroll
  for (int d0 = 0; d0 < 8; ++d0) qr[d0] = ld8(Qw + d0 * 16);
  const int sr = tid >> 4, sc = (tid & 15) * 8, vst0 = v_st(sr, sc), vst1 = v_st(32 + sr, sc);
  const int vb0 = (int)(uintptr_t)V_lds + v_rd_base(lane);
  struct { bf16x8 vs0, vs1, ks0, ks1; } sr_[SDEPTH];
#define SLOAD(i, k0) do { sr_[i].vs0 = ld8(&Vh[(long)((k0) + sr) * LDK + sc]); sr_[i].vs1 = ld8(&Vh[(long)((k0) + 32 + sr) * LDK + sc]); \
    sr_[i].ks0 = ld8(&Kh[(long)((k0) + sr) * LDK + sc]); sr_[i].ks1 = ld8(&Kh[(long)((k0) + 32 + sr) * LDK + sc]); } while (0)
#define SWRITE(soff, i) do { *(bf16x8*)((char*)V_lds + (soff) + vst0) = sr_[i].vs0;          \
    *(bf16x8*)((char*)V_lds + (soff) + vst1) = sr_[i].vs1; int kc = sc * 2;               \
    *(bf16x8*)((char*)K_lds + (soff) + KSWZ(sr, kc)) = sr_[i].ks0;                       \
    *(bf16x8*)((char*)K_lds + (soff) + KSWZ(32 + sr, kc)) = sr_[i].ks1; } while (0)
#define SWAIT() do { if constexpr (SDEPTH == 2) asm volatile("s_waitcnt vmcnt(4)" ::: "memory"); else asm volatile("s_waitcnt vmcnt(0)" ::: "memory"); } while (0)
#define ROT() do { const int t_ = s_prev; s_prev = s_cur; s_cur = s_next; s_next = t_; } while (0)
  f32x16 pA0, pA1, pB0, pB1; bf16x8 pa0, pa1, pa2, pa3; const int NT = seq / KVBLK;
  constexpr int SE = 0, SO = SDEPTH - 1;
  int s_prev = 0, s_cur = (int)SHM_V, s_next = 2 * (int)SHM_V;
  SLOAD(SE, 0); asm volatile("s_waitcnt vmcnt(0)" ::: "memory"); SWRITE(0, SE); __syncthreads();
  qkt(pA0, pA1, K_lds, qr, negm, r32, hi); if constexpr (!LATE) partialSM(pA0);
  SLOAD(SO, KVBLK); if constexpr (SDEPTH == 2) { if (2 < NT) SLOAD(SE, 2 * KVBLK); }
  SWAIT(); SWRITE(s_cur, SO); __syncthreads();
  for (int j = 1; j + 1 < NT; j += 2) {
    if constexpr (LATE) { partialSM(pA0); }
    SBAR(); qkt(pB0, pB1, (bf16*)((char*)K_lds + s_cur), qr, negm, r32, hi);
    finishSM(pA0, pA1, l_reg, pa0, pa1, pa2, pa3); SBAR();
    SLOAD(SO, (j + SDEPTH) * KVBLK); SBAR();
    pv_d0(o, vb0 + s_prev, pa0, pa1, pa2, pa3); if constexpr (!LATE) partialSM(pB0);
    SWAIT(); SWRITE(s_next, SE);
    __syncthreads(); ROT();
    if constexpr (LATE) { partialSM(pB0); }
    SBAR(); qkt(pA0, pA1, (bf16*)((char*)K_lds + s_cur), qr, negm, r32, hi);
    finishSM(pB0, pB1, l_reg, pa0, pa1, pa2, pa3); SBAR();
    if (SDEPTH == 1 || j + 3 < NT) SLOAD(SE, (j + 1 + SDEPTH) * KVBLK); SBAR();
    pv_d0(o, vb0 + s_prev, pa0, pa1, pa2, pa3); if constexpr (!LATE) partialSM(pA0);
    SWAIT(); SWRITE(s_next, SO);
    __syncthreads(); ROT();
  }
  if constexpr (LATE) { partialSM(pA0); }
  SBAR(); qkt(pB0, pB1, (bf16*)((char*)K_lds + s_cur), qr, negm, r32, hi);
  finishSM(pA0, pA1, l_reg, pa0, pa1, pa2, pa3); SBAR();
  pv_d0(o, vb0 + s_prev, pa0, pa1, pa2, pa3); partialSM(pB0);
  finishSM(pB0, pB1, l_reg, pa0, pa1, pa2, pa3); SBAR();
  pv_d0(o, vb0 + s_cur, pa0, pa1, pa2, pa3);
  if (hi == 0) li_l[r32] = l_reg; asm volatile("s_waitcnt lgkmcnt(0)" ::: "memory");
  float rli[16];
#pragma unroll
  for (int r = 0; r < 16; ++r) rli[r] = __builtin_amdgcn_rcpf(li_l[crow(r, hi)]);
  __syncthreads();
  { bf16* stg = (bf16*)(lds + wid * 8704);
#pragma unroll
    for (int r = 0; r < 16; ++r) { const int orow = crow(r, hi);
#pragma unroll
      for (int d0 = 0; d0 < 4; ++d0) { const float v = o[d0][r] * rli[r]; const unsigned u = __float_as_uint(v); stg[orow * 136 + d0 * 32 + r32] = (bf16)((u + 0x7fffu + ((u >> 16) & 1u)) >> 16); } }
    asm volatile("s_waitcnt lgkmcnt(0)" ::: "memory");
    const bf16* Zw = Zb + (long)(wid * QBLK) * LDZ; bf16* Mw = Mb + (long)(wid * QBLK) * LDM;
    u32x4 zv[8];
#pragma unroll
    for (int i = 0; i < 8; ++i) { const int c = lane + 64 * i, row = c >> 4, c8 = (c & 15) * 8; zv[i] = *(const u32x4*)(Zw + (long)row * LDZ + c8); }
#pragma unroll
    for (int i = 0; i < 8; ++i) { const int c = lane + 64 * i, row = c >> 4, c8 = (c & 15) * 8; const u32x4 ov = *(const u32x4*)(stg + row * 136 + c8); u32x4 w;
#pragma unroll
      for (int e = 0; e < 4; ++e) { const float z0 = __uint_as_float(zv[i][e] << 16), z1 = __uint_as_float(zv[i][e] & 0xffff0000u);
        const float a0 = __uint_as_float(ov[e] << 16) * z0 * __builtin_amdgcn_rcpf(1.0f + __expf(-z0)), a1 = __uint_as_float(ov[e] & 0xffff0000u) * z1 * __builtin_amdgcn_rcpf(1.0f + __expf(-z1));
        w[e] = cvtpk(a0, a1); }
      *(u32x4*)(Mw + (long)row * LDM + c8) = w; }
  }
  __syncthreads();
#undef SLOAD
#undef SWRITE
#undef SWAIT
#undef ROT
}
__device__ __forceinline__ void attn_dense_body(const bf16* __restrict__ Qb, const bf16* __restrict__ Kh, const bf16* __restrict__ Vh,
                                                const bf16* __restrict__ Zb, bf16* __restrict__ Mb, int seq, float negmv, char* lds) {
  if (__builtin_amdgcn_readfirstlane((int)threadIdx.x >> 6) < 4) attn_dense_half<false>(Qb, Kh, Vh, Zb, Mb, seq, negmv, lds);
  else attn_dense_half<true>(Qb, Kh, Vh, Zb, Mb, seq, negmv, lds);
}
#undef KSWZ
#undef SBAR
}
typedef unsigned short bf16_t;
typedef short bf16x8 __attribute__((ext_vector_type(8)));
typedef float f32x4 __attribute__((ext_vector_type(4)));
typedef float f32x8 __attribute__((ext_vector_type(8)));
typedef unsigned u32x4 __attribute__((ext_vector_type(4)));
typedef unsigned u32x2 __attribute__((ext_vector_type(2)));
#define LAS __attribute__((address_space(3)))
constexpr size_t al256(size_t x) { return (x + 255) / 256 * 256; }
constexpr size_t W_MISC = 32768;
constexpr size_t W_WIN = 1u << 20;
constexpr size_t SZ_WIN = (size_t)NPROJ * DM * 2, SZ_WOUT = (size_t)DM * DM * 2, SZ_WGLU = (size_t)512 * 512 * 2;
constexpr size_t W_WOUT = W_WIN + 2 * SZ_WIN;
constexpr size_t W_WGLU = W_WOUT + 2 * SZ_WOUT;
constexpr size_t W_XN = W_WGLU + 2 * SZ_WGLU;
constexpr size_t W_PROJ = W_XN + (size_t)NROWS * DM * 2;
constexpr size_t W_GRAW = W_PROJ + (size_t)NROWS * 6144 * 2;
constexpr size_t W_GD = W_GRAW + (size_t)NROWS * 16 * 4;
constexpr size_t W_CQ = W_GD + (size_t)NROWS * 16 * 4;
constexpr size_t W_CK = W_CQ + (size_t)NROWS * 512 * 2;
constexpr size_t W_STC = W_CK + (size_t)NROWS * 512 * 2;
constexpr size_t W_STN = W_STC + (size_t)16 * 66 * 16384 * 4;
constexpr size_t W_STS = W_STN + (size_t)16 * 66 * 128 * 4;
constexpr size_t W_S5F = W_STS + al256(16 * 66 * 4 * 4);
constexpr size_t W_HCTX = W_S5F + (size_t)2 * 32 * 2 * 66 * 128 * 4;
constexpr size_t W_ROPE = W_HCTX + (size_t)512 * DM * 4;
constexpr size_t W_ADAP = W_ROPE + (size_t)SEQ * 64 * 2 * 4;
constexpr size_t W_ADA = W_ADAP + (size_t)2 * 128 * 3 * 6144 * 4;
constexpr size_t W_LAM = W_ADA + (size_t)2 * 3 * 6144 * 4;
constexpr size_t W_LAMT = W_LAM + (size_t)2 * 2 * 32 * 64 * 2 * 4;
constexpr size_t W_BBT = W_LAMT + (size_t)2 * 2 * 32 * 64 * 2 * 4;
constexpr size_t W_CMT = W_BBT + (size_t)2 * 2 * 32 * 128 * 16 * 4;
constexpr size_t W_CB = W_CMT + (size_t)2 * 2 * 32 * 128 * 16 * 4;
constexpr size_t W_SLOTS = W_CB + (size_t)16 * 66 * 16384 * 2;
constexpr size_t W_END = W_SLOTS + (size_t)66 * 8 * 256 * 4;
static_assert(W_END <= (size_t)512 * 1024 * 1024, "workspace map exceeds 512 MiB");
constexpr int SEC_S5U = 0, SEC_S5Z = 512, SEC_ATQ = 1024, SEC_ATK = 2048, SEC_ATV = 2304, SEC_ATZ = 2560, SEC_MLQ = 3584, SEC_MLK = 4096, SEC_MLV = 4608, SEC_MLO = 5120, SEC_MLZ = 5632;
constexpr int LDS_BYTES = 147456;
constexpr int NTHR = 512;

struct Params { const float* in[25]; float* out; unsigned char* ws; };
enum { I_X = 0, I_C, I_CTX, I_CCTX, I_NORMW, I_ADAW, I_ADAB, I_WIN, I_GATEB, I_ARE, I_AIM, I_LOGDT, I_BRE, I_BIM, I_CRE, I_CIM, I_SSMD, I_WGLU, I_QNORM, I_KNORM, I_CONVW, I_CONVB, I_MNORM, I_WOUT, I_FNORM };

__device__ __forceinline__ float bf2f(unsigned short b) { return __uint_as_float(((unsigned)b) << 16); }
__device__ __forceinline__ unsigned short f2bf(float f) { unsigned u = __float_as_uint(f); return (unsigned short)((u + 0x7fffu + ((u >> 16) & 1u)) >> 16); }
typedef float f32x2_t __attribute__((ext_vector_type(2))); typedef __bf16 bf16x2_t __attribute__((ext_vector_type(2)));
__device__ __forceinline__ unsigned pk2(float lo, float hi) { f32x2_t v = {lo, hi}; bf16x2_t b = __builtin_convertvector(v, bf16x2_t); return __builtin_bit_cast(unsigned, b); }
__device__ __forceinline__ float lo16(unsigned w) { return __uint_as_float(w << 16); }
__device__ __forceinline__ float hi16(unsigned w) { return __uint_as_float(w & 0xffff0000u); }
__device__ __forceinline__ float sigm(float x) { return __builtin_amdgcn_rcpf(1.0f + __expf(-x)); }
__device__ __forceinline__ float silu(float x) { return x * __builtin_amdgcn_rcpf(1.0f + __expf(-x)); }
__device__ __forceinline__ float wave_sum(float v) {
#pragma unroll
    for (int o = 1; o < 64; o <<= 1) v += __shfl_xor(v, o);
    return v;
}
__device__ __forceinline__ float gelu_tanh(float x) { const float u = 0.7978845608028654f * (x + 0.044715f * x * x * x); return x * __builtin_amdgcn_rcpf(1.0f + __expf(-2.0f * u)); }

__device__ __forceinline__ int win_col_map(int n) { return n < 5632 ? n : (n < 6144 ? n + 16 : (n < 6160 ? n - 512 : -1)); }
__device__ __forceinline__ void transpose_load(f32x4 (&v)[8], const float* W, int N, int nNew, bool remap, int item, int lane) {
    const int nblk = nNew / 32, kb = item / nblk, nb = item % nblk, k0 = 64 * kb, n0 = 32 * nb;
    const int n4 = (lane & 7) * 4, kr = lane >> 3; const int nn = n0 + n4; const int oc = remap ? win_col_map(nn) : nn;
#pragma unroll
    for (int i = 0; i < 8; ++i) v[i] = oc >= 0 ? *(const f32x4*)(W + (size_t)(k0 + i * 8 + kr) * N + oc) : (f32x4){0.f, 0.f, 0.f, 0.f};
}
__device__ __forceinline__ void transpose_finish(const f32x4 (&v)[8], int K, bf16_t* WT, int nNew, float* scr, int item, int lane) {
    const int nblk = nNew / 32, kb = item / nblk, nb = item % nblk, k0 = 64 * kb, n0 = 32 * nb;
    const int n4 = (lane & 7) * 4, kr = lane >> 3;
#pragma unroll
    for (int i = 0; i < 8; ++i) *(f32x4*)(scr + (i * 8 + kr) * 36 + n4) = v[i];
    asm volatile("s_waitcnt lgkmcnt(0)" ::: "memory");
    const int c = lane & 7;
#pragma unroll
    for (int j = 0; j < 4; ++j) { const int n = (lane >> 3) + 8 * j; const float* s = scr + (8 * c) * 36 + n;
        u32x4 o; o.x = pk2(s[0 * 36], s[1 * 36]); o.y = pk2(s[2 * 36], s[3 * 36]); o.z = pk2(s[4 * 36], s[5 * 36]); o.w = pk2(s[6 * 36], s[7 * 36]);
        *(u32x4*)(WT + (size_t)(n0 + n) * K + k0 + 8 * c) = o; }
    asm volatile("s_waitcnt lgkmcnt(0)" ::: "memory");
}
constexpr int WT_IN = 32 * (NPROJ / 32), WT_OUT = 32 * (DM / 32), WT_GL = 8 * 16, WT_ITEMS = WT_IN + WT_OUT + WT_GL;
struct WtItem { const float* W; bf16_t* WT; int K, N, nNew, item; bool remap; };
__device__ __forceinline__ WtItem wt_item(const Params& p, int it) {
    unsigned char* ws = p.ws; const int l = it / WT_ITEMS; int r = it % WT_ITEMS; WtItem w;
    if (r < WT_IN) { w.W = p.in[I_WIN] + (size_t)l * DM * NCOL_IN; w.WT = (bf16_t*)(ws + W_WIN + l * SZ_WIN); w.K = DM; w.N = NCOL_IN; w.nNew = NPROJ; w.item = r; w.remap = true; return w; } r -= WT_IN;
    if (r < WT_OUT) { w.W = p.in[I_WOUT] + (size_t)l * DM * DM; w.WT = (bf16_t*)(ws + W_WOUT + l * SZ_WOUT); w.K = DM; w.N = DM; w.nNew = DM; w.item = r; w.remap = false; return w; } r -= WT_OUT;
    w.W = p.in[I_WGLU] + (size_t)l * 512 * 512; w.WT = (bf16_t*)(ws + W_WGLU + l * SZ_WGLU); w.K = 512; w.N = 512; w.nNew = 512; w.item = r; w.remap = false; return w;
}
__device__ __forceinline__ void p0_prologue(const Params& p, char* lds, int G) {
    unsigned char* ws = p.ws;
    int tid_o = threadIdx.x; asm volatile("" : "+v"(tid_o)); const int tid = tid_o, lane = tid & 63, wave = tid >> 6;
    const int gw = blockIdx.x * 8 + wave, NGW = G * 8;
    const int gt = blockIdx.x * NTHR + tid, NGT = G * NTHR;
    {
        float* act = (float*)lds;
        float* part = (float*)(ws + W_ADAP);
        for (int it = blockIdx.x; it < 256; it += G) {
            const int l = it >> 7, ks = it & 127;
            __syncthreads();
            if (tid < 48) { const int v = tid >> 4, kk = tid & 15, k = ks * 16 + kk; const float cv = (v < 2) ? p.in[I_C][v * DM + k] : p.in[I_CCTX][k]; act[tid] = silu(cv); }
            __syncthreads();
            const float* W = p.in[I_ADAW] + (size_t)l * DM * 6144 + (size_t)(ks * 16) * 6144 + 4 * tid;
            f32x4 a[3][3];
#pragma unroll
            for (int v = 0; v < 3; ++v)
#pragma unroll
                for (int j = 0; j < 3; ++j) a[v][j] = (f32x4){0.f, 0.f, 0.f, 0.f};
#pragma unroll
            for (int kk = 0; kk < 16; ++kk) {
                const float a0 = act[kk], a1 = act[16 + kk], a2 = act[32 + kk];
#pragma unroll
                for (int j = 0; j < 3; ++j) { const f32x4 w = *(const f32x4*)(W + (size_t)kk * 6144 + 2048 * j); a[0][j] += w * a0; a[1][j] += w * a1; a[2][j] += w * a2; }
            }
            float* po = part + (size_t)((l * 128 + ks) * 3) * 6144 + 4 * tid;
#pragma unroll
            for (int v = 0; v < 3; ++v)
#pragma unroll
                for (int j = 0; j < 3; ++j) *(f32x4*)(po + (size_t)v * 6144 + 2048 * j) = a[v][j];
        }
        __syncthreads();
    }
    {
        float* scr = (float*)(lds + wave * 9216);
        f32x4 v[8], vn[8];
        int it = gw;
        if (it < 2 * WT_ITEMS) { const WtItem w = wt_item(p, it); transpose_load(v, w.W, w.N, w.nNew, w.remap, w.item, lane); }
        for (; it < 2 * WT_ITEMS; it += NGW) {
            const int nit = it + NGW;
            if (nit < 2 * WT_ITEMS) { const WtItem wn = wt_item(p, nit); transpose_load(vn, wn.W, wn.N, wn.nNew, wn.remap, wn.item, lane); }
            const WtItem w = wt_item(p, it); transpose_finish(v, w.K, w.WT, w.nNew, scr, w.item, lane);
#pragma unroll
            for (int i = 0; i < 8; ++i) v[i] = vn[i];
        }
    }
    for (int idx16 = gt; idx16 < 2 * 2 * 32 * 64 * 16; idx16 += NGT) {
        const int j = idx16 & 15, idx = idx16 >> 4;
        const int n = idx & 63, g = (idx >> 6) & 31, dir = (idx >> 11) & 1, l = idx >> 12;
        const int ld = l * 2 + dir;
        const float a_re = p.in[I_ARE][(ld * 32 + g) * 64 + n], a_im = p.in[I_AIM][(ld * 32 + g) * 64 + n];
        const float dt = expf(p.in[I_LOGDT][ld * 32 + g]);
        const float mag = expf(a_re * dt); const float lam_re = mag * cosf(a_im * dt), lam_im = mag * sinf(a_im * dt);
        const float inv = 1.0f / (a_re * a_re + a_im * a_im);
        const float nr = lam_re - 1.0f, ni = lam_im;
        const float f_re = (nr * a_re + ni * a_im) * inv, f_im = (ni * a_re - nr * a_im) * inv;
        if (j == 0) {
            float* LAM = (float*)(ws + W_LAM); float* LAMT = (float*)(ws + W_LAMT);
            LAM[idx * 2] = lam_re; LAM[idx * 2 + 1] = lam_im;
            const double are = (double)a_re * (double)dt * 128.0, aim = (double)a_im * (double)dt * 128.0; const double mg = exp(are);
            LAMT[idx * 2] = (float)(mg * cos(aim)); LAMT[idx * 2 + 1] = (float)(mg * sin(aim));
        }
        float* BBT = (float*)(ws + W_BBT) + (size_t)((ld * 32 + g) * 128) * 16;
        { const int q = j; const float br = p.in[I_BRE][((l * 32 + g) * 16 + q) * 64 + n], bi = p.in[I_BIM][((l * 32 + g) * 16 + q) * 64 + n];
            BBT[n * 16 + q] = f_re * br - f_im * bi; BBT[(64 + n) * 16 + q] = f_re * bi + f_im * br; }
        float* CMT = (float*)(ws + W_CMT) + (size_t)((ld * 32 + g) * 16) * 128;
        { const int pp = j; const float cr = p.in[I_CRE][((ld * 32 + g) * 16 + pp) * 64 + n], ci = p.in[I_CIM][((ld * 32 + g) * 16 + pp) * 64 + n];
            CMT[pp * 128 + n] = cr; CMT[pp * 128 + 64 + n] = -ci; }
    }
    if (blockIdx.x == 0 && tid < 2) { const float* qw = p.in[I_QNORM] + tid * 128; const float* kw = p.in[I_KNORM] + tid * 128; float mq = 0.f, mk = 0.f;
        for (int i = 0; i < 128; ++i) { mq = fmaxf(mq, fabsf(qw[i])); mk = fmaxf(mk, fabsf(kw[i])); }
        ((float*)(ws + W_MISC))[tid] = -fminf((128.0f * 0.088388347648318440f * 1.4426950408889634f * 1.02f) * mq * mk, 64.0f); }
    for (int idx = gt; idx < SEQ * 64; idx += NGT) {
        const int t = idx >> 6, d = idx & 63; const float inv = exp2f(-(float)(d & 31) * (13.287712379549449f / 32.0f));
        const float pos = (d < 32) ? (float)(t >> 6) : (float)(t & 63); const float ang = pos * inv;
        float* RP = (float*)(ws + W_ROPE); RP[idx * 2] = cosf(ang); RP[idx * 2 + 1] = sinf(ang);
    }
}
__device__ __forceinline__ void p0b_ada(const Params& p, int G) {
    int tid_o = threadIdx.x; asm volatile("" : "+v"(tid_o)); const int gt = blockIdx.x * NTHR + tid_o, NGT = G * NTHR;
    const float* part = (const float*)(p.ws + W_ADAP); float* ada = (float*)(p.ws + W_ADA);
    for (int idx = gt; idx < 2 * 3 * 6144; idx += NGT) {
        const int l = idx / 18432, v = (idx / 6144) % 3, j = idx % 6144;
        float s = p.in[I_ADAB][l * 6144 + j];
#pragma unroll 16
        for (int ks = 0; ks < 128; ++ks) s += part[(size_t)((l * 128 + ks) * 3 + v) * 6144 + j];
        ada[idx] = s;
    }
}
struct XnRow { const float* src; const bf16_t* dl; };
__device__ __forceinline__ XnRow xn_src(const Params& p, int layer, int row) {
    const int b = row / RB, r = row % RB; const bool isc = r < CTX; XnRow x; x.dl = nullptr;
    if (isc) x.src = (layer == 0 ? p.in[I_CTX] : (const float*)(p.ws + W_HCTX)) + (size_t)(b * CTX + r) * DM;
    else { x.src = p.in[I_X] + (size_t)(b * SEQ + r - CTX) * DM; if (layer == 1) x.dl = (const bf16_t*)p.out + (size_t)(b * SEQ + r - CTX) * (2 * DM); }
    return x;
}
__device__ __forceinline__ void xn_load(f32x4 (&v)[8], u32x2 (&d)[8], const XnRow& x, int lane) {
#pragma unroll
    for (int j = 0; j < 8; ++j) { v[j] = *(const f32x4*)(x.src + 4 * lane + 256 * j); d[j] = x.dl ? *(const u32x2*)(x.dl + 4 * lane + 256 * j) : (u32x2){0u, 0u}; }
}
__device__ __forceinline__ void p1_xn(const Params& p, int layer, int G) {
    int tid_o = threadIdx.x; asm volatile("" : "+v"(tid_o)); const int tid = tid_o, lane = tid & 63, wave = tid >> 6; const int gw = blockIdx.x * 8 + wave, NGW = G * 8;
    const float* ada = (const float*)(p.ws + W_ADA) + layer * 3 * 6144; const float* nw = p.in[I_NORMW] + layer * DM;
    bf16_t* XN = (bf16_t*)(p.ws + W_XN);
    f32x4 w[8];
#pragma unroll
    for (int j = 0; j < 8; ++j) w[j] = *(const f32x4*)(nw + 4 * lane + 256 * j);
    f32x4 v[8], vn[8]; u32x2 d[8], dn[8];
    int row = gw;
    if (row < NROWS) xn_load(v, d, xn_src(p, layer, row), lane);
    for (; row < NROWS; row += NGW) {
        const int nrow = row + NGW;
        if (nrow < NROWS) xn_load(vn, dn, xn_src(p, layer, nrow), lane);
        const int b = row / RB, r = row % RB; const bool isc = r < CTX;
        const float* av = ada + (isc ? 2 : b) * 6144;
        f32x4 sh[8], sc[8];
#pragma unroll
        for (int j = 0; j < 8; ++j) { sh[j] = *(const f32x4*)(av + 4 * lane + 256 * j); sc[j] = *(const f32x4*)(av + 2048 + 4 * lane + 256 * j); }
        float ss = 0.f;
#pragma unroll
        for (int j = 0; j < 8; ++j) { v[j].x += lo16(d[j].x); v[j].y += hi16(d[j].x); v[j].z += lo16(d[j].y); v[j].w += hi16(d[j].y);
            ss += (v[j].x * v[j].x + v[j].y * v[j].y) + (v[j].z * v[j].z + v[j].w * v[j].w); }
        const float rstd = rsqrtf(wave_sum(ss) * (1.0f / DM) + EPSN);
#pragma unroll
        for (int j = 0; j < 8; ++j) { const int c = 4 * lane + 256 * j;
            const f32x4 y = (v[j] * rstd * w[j]) * (sc[j] + 1.0f) + sh[j];
            u32x2 o; o.x = pk2(y.x, y.y); o.y = pk2(y.z, y.w); *(u32x2*)(XN + (size_t)row * DM + c) = o; }
#pragma unroll
        for (int j = 0; j < 8; ++j) { v[j] = vn[j]; d[j] = dn[j]; }
    }
}
__device__ __forceinline__ void p_final(const Params& p, int G) {
    int tid_o = threadIdx.x; asm volatile("" : "+v"(tid_o)); const int tid = tid_o, lane = tid & 63, wave = tid >> 6; const int gw = blockIdx.x * 8 + wave, NGW = G * 8;
    const float* nw = p.in[I_FNORM]; const bf16_t* D1 = (const bf16_t*)(p.ws + W_PROJ); const bf16_t* D0 = (const bf16_t*)p.out;
    f32x4 w[8];
#pragma unroll
    for (int j = 0; j < 8; ++j) w[j] = *(const f32x4*)(nw + 4 * lane + 256 * j);
    f32x4 v[8], vn[8]; u32x2 d0[8], d0n[8], d1[8], d1n[8];
    int row = gw;
    if (row < NBATCH * SEQ) {
#pragma unroll
        for (int j = 0; j < 8; ++j) { const int c = 4 * lane + 256 * j; v[j] = *(const f32x4*)(p.in[I_X] + (size_t)row * DM + c); d0[j] = *(const u32x2*)(D0 + (size_t)row * (2 * DM) + c); d1[j] = *(const u32x2*)(D1 + (size_t)row * DM + c); } }
    for (; row < NBATCH * SEQ; row += NGW) {
        const int nrow = row + NGW;
        if (nrow < NBATCH * SEQ) {
#pragma unroll
            for (int j = 0; j < 8; ++j) { const int c = 4 * lane + 256 * j; vn[j] = *(const f32x4*)(p.in[I_X] + (size_t)nrow * DM + c); d0n[j] = *(const u32x2*)(D0 + (size_t)nrow * (2 * DM) + c); d1n[j] = *(const u32x2*)(D1 + (size_t)nrow * DM + c); } }
        float ss = 0.f;
#pragma unroll
        for (int j = 0; j < 8; ++j) { v[j].x += lo16(d0[j].x) + lo16(d1[j].x); v[j].y += hi16(d0[j].x) + hi16(d1[j].x); v[j].z += lo16(d0[j].y) + lo16(d1[j].y); v[j].w += hi16(d0[j].y) + hi16(d1[j].y);
            ss += (v[j].x * v[j].x + v[j].y * v[j].y) + (v[j].z * v[j].z + v[j].w * v[j].w); }
        const float rstd = rsqrtf(wave_sum(ss) * (1.0f / DM) + EPSN);
        float* dst = p.out + (size_t)row * DM;
#pragma unroll
        for (int j = 0; j < 8; ++j) *(f32x4*)(dst + 4 * lane + 256 * j) = v[j] * rstd * w[j];
#pragma unroll
        for (int j = 0; j < 8; ++j) { v[j] = vn[j]; d0[j] = d0n[j]; d1[j] = d1n[j]; }
    }
}
constexpr float ATT_QSCALE = 0.088388347648318440f * 1.4426950408889634f;
struct NrLoad { u32x4 a, b; f32x4 r0, r1, r2, r3; };
__device__ __forceinline__ void nr_load(NrLoad& L, const bf16_t* ptr, const float* RP, int t, int d0) {
    L.a = *(const u32x4*)(ptr + d0); L.b = *(const u32x4*)(ptr + 64 + d0);
    const float* rp = RP + ((size_t)(t < 0 ? 0 : t) * 64 + d0) * 2;
    L.r0 = *(const f32x4*)rp; L.r1 = *(const f32x4*)(rp + 4); L.r2 = *(const f32x4*)(rp + 8); L.r3 = *(const f32x4*)(rp + 12);
}
__device__ __forceinline__ void nr_finish(const NrLoad& L, bf16_t* ptr, bool isc, int d0, const f32x4 (&w)[4], float osc) {
    float x1[8], x2[8]; float ss = 0.f;
#pragma unroll
    for (int i = 0; i < 4; ++i) { x1[2 * i] = lo16(L.a[i]); x1[2 * i + 1] = hi16(L.a[i]); x2[2 * i] = lo16(L.b[i]); x2[2 * i + 1] = hi16(L.b[i]); }
#pragma unroll
    for (int i = 0; i < 8; ++i) ss += x1[i] * x1[i] + x2[i] * x2[i];
    ss += __shfl_xor(ss, 1); ss += __shfl_xor(ss, 2); ss += __shfl_xor(ss, 4);
    const float rstd = rsqrtf(ss * (1.0f / 128.0f) + EPSN);
    const float cs[8] = {L.r0.x, L.r0.z, L.r1.x, L.r1.z, L.r2.x, L.r2.z, L.r3.x, L.r3.z}, sn[8] = {L.r0.y, L.r0.w, L.r1.y, L.r1.w, L.r2.y, L.r2.w, L.r3.y, L.r3.w};
    float o1[8], o2[8];
#pragma unroll
    for (int i = 0; i < 8; ++i) { const float y1 = x1[i] * rstd * w[i >> 2][i & 3], y2 = x2[i] * rstd * w[2 + (i >> 2)][i & 3];
        const float c = isc ? 1.0f : cs[i], s = isc ? 0.0f : sn[i]; o1[i] = (y1 * c - y2 * s) * osc; o2[i] = (y1 * s + y2 * c) * osc; }
    u32x4 wa, wb;
#pragma unroll
    for (int i = 0; i < 4; ++i) { wa[i] = pk2(o1[2 * i], o1[2 * i + 1]); wb[i] = pk2(o2[2 * i], o2[2 * i + 1]); }
    *(u32x4*)(ptr + d0) = wa; *(u32x4*)(ptr + 64 + d0) = wb;
}
__device__ __forceinline__ void p3_post(const Params& p, int layer, int G) {
    unsigned char* ws = p.ws;
    int tid_o = threadIdx.x; asm volatile("" : "+v"(tid_o)); const int tid = tid_o, lane = tid & 63, wave = tid >> 6;
    const int gw = blockIdx.x * 8 + wave, NGW = G * 8;
    const int gt = blockIdx.x * NTHR + tid, NGT = G * NTHR;
    bf16_t* PROJ = (bf16_t*)(ws + W_PROJ);
    const float* RP = (const float*)(ws + W_ROPE);
    const int d0 = (lane & 7) * 8;
    {
        bf16_t* ATQ = PROJ + (size_t)NROWS * SEC_ATQ; const float* qnw = p.in[I_QNORM] + layer * 128;
        f32x4 w[4]; w[0] = *(const f32x4*)(qnw + d0); w[1] = *(const f32x4*)(qnw + d0 + 4); w[2] = *(const f32x4*)(qnw + 64 + d0); w[3] = *(const f32x4*)(qnw + 64 + d0 + 4);
        const int hd = lane >> 3;
        for (int row = gw; row < NROWS; row += 3 * NGW) {
            NrLoad L[3]; bf16_t* ptr[3]; bool isc[3]; bool ok[3];
#pragma unroll
            for (int q = 0; q < 3; ++q) { const int rr = row + q * NGW; ok[q] = rr < NROWS; const int r2 = ok[q] ? rr : row; const int r = r2 % RB; isc[q] = r < CTX;
                ptr[q] = ATQ + (size_t)r2 * 1024 + hd * 128; nr_load(L[q], ptr[q], RP, r - CTX, d0); }
#pragma unroll
            for (int q = 0; q < 3; ++q) if (ok[q]) nr_finish(L[q], ptr[q], isc[q], d0, w, ATT_QSCALE);
        }
    }
    {
        bf16_t* ATK = PROJ + (size_t)NROWS * SEC_ATK; const float* knw = p.in[I_KNORM] + layer * 128;
        f32x4 w[4]; w[0] = *(const f32x4*)(knw + d0); w[1] = *(const f32x4*)(knw + d0 + 4); w[2] = *(const f32x4*)(knw + 64 + d0); w[3] = *(const f32x4*)(knw + 64 + d0 + 4);
        const int hd = (lane >> 3) & 1, rs = lane >> 4;
        for (int rq = gw; rq < NROWS / 4; rq += 3 * NGW) {
            NrLoad L[3]; bf16_t* ptr[3]; bool isc[3]; bool ok[3];
#pragma unroll
            for (int q = 0; q < 3; ++q) { const int r4 = rq + q * NGW; ok[q] = r4 < NROWS / 4; const int r2 = (ok[q] ? r4 : rq) * 4 + rs; const int r = r2 % RB; isc[q] = r < CTX;
                ptr[q] = ATK + (size_t)r2 * 256 + hd * 128; nr_load(L[q], ptr[q], RP, r - CTX, d0); }
#pragma unroll
            for (int q = 0; q < 3; ++q) if (ok[q]) nr_finish(L[q], ptr[q], isc[q], d0, w, 1.0f);
        }
    }
    {
        const bf16_t* MLQ = PROJ + (size_t)NROWS * SEC_MLQ; const bf16_t* MLK = PROJ + (size_t)NROWS * SEC_MLK;
        bf16_t* CQ = (bf16_t*)(ws + W_CQ); bf16_t* CK = (bf16_t*)(ws + W_CK);
        const float* cw = p.in[I_CONVW] + layer * 3 * 1024; const float* cb = p.in[I_CONVB] + layer * 1024;
        for (int it = gw; it < 2048; it += NGW) {
            const int rb = it >> 2, quarter = it & 3; const int ch = quarter * 256 + lane * 4; const bool isk = quarter >= 2; const int cc = ch & 511;
            const f32x4 w0 = *(const f32x4*)(cw + ch), w1 = *(const f32x4*)(cw + 1024 + ch), w2 = *(const f32x4*)(cw + 2048 + ch), bb = *(const f32x4*)(cb + ch);
            const float osc = isk ? 0.08838834764831845f : 1.0f;
            const bf16_t* src = (isk ? MLK : MLQ) + cc; bf16_t* dst = (isk ? CK : CQ) + cc;
            const int r0 = rb * 33;
            u32x2 xv[35];
#pragma unroll
            for (int i = 0; i < 35; ++i) { const int r = r0 - 1 + i; xv[i] = (r >= 0 && r < NROWS) ? *(const u32x2*)(src + (size_t)r * 512) : (u32x2){0u, 0u}; }
#pragma unroll
            for (int i = 0; i < 33; ++i) { const int row = r0 + i; const int r = row % RB; const bool isc = r < CTX; const int t = isc ? r : r - CTX, len = isc ? CTX : SEQ;
                const u32x2 xp = (t > 0) ? xv[i] : (u32x2){0u, 0u}, xc = xv[i + 1], xn = (t < len - 1) ? xv[i + 2] : (u32x2){0u, 0u};
                float y0 = w0.x * lo16(xp.x) + w1.x * lo16(xc.x) + w2.x * lo16(xn.x) + bb.x, y1 = w0.y * hi16(xp.x) + w1.y * hi16(xc.x) + w2.y * hi16(xn.x) + bb.y;
                float y2 = w0.z * lo16(xp.y) + w1.z * lo16(xc.y) + w2.z * lo16(xn.y) + bb.z, y3 = w0.w * hi16(xp.y) + w1.w * hi16(xc.y) + w2.w * hi16(xn.y) + bb.w;
                u32x2 o; o.x = pk2(silu(y0) * osc, silu(y1) * osc); o.y = pk2(silu(y2) * osc, silu(y3) * osc);
                *(u32x2*)(dst + (size_t)row * 512) = o; }
        }
    }
    {
        const float* graw = (const float*)(ws + W_GRAW); float* gd = (float*)(ws + W_GD); const float* gb = p.in[I_GATEB] + layer * 16;
        for (long idx = gt; idx < (long)NROWS * 16; idx += NGT) {
            const int j = (int)(idx & 15); const float x = graw[idx] + gb[j];
            float y = x;
            if ((j >> 2) & 1) y = fminf(x, 0.f) - log1pf(__expf(-fabsf(x)));
            gd[idx] = y;
        }
    }
}
__device__ __forceinline__ void p4_attn(const Params& p, int layer, int G, char* lds) {
    unsigned char* ws = p.ws; const bf16_t* PROJ = (const bf16_t*)(ws + W_PROJ); bf16_t* MIX = (bf16_t*)(ws + W_XN);
    const bf16_t* ATQ = PROJ + (size_t)NROWS * SEC_ATQ; const bf16_t* ATK = PROJ + (size_t)NROWS * SEC_ATK; const bf16_t* ATV = PROJ + (size_t)NROWS * SEC_ATV; const bf16_t* ATZ = PROJ + (size_t)NROWS * SEC_ATZ;
    const int bx = blockIdx.x; const int vcu = (G % 8 == 0) ? (bx % 8) * (G / 8) + bx / 8 : bx;
    const int nunits = 512 + (layer == 0 ? 16 : 0);
    for (int u = vcu; u < nunits; u += G) {
        int b, h, rowq, seq;
        if (u < 512) { const int combo = u >> 7, within = u & 127; b = combo >> 1; const int kvh = combo & 1; h = kvh * 4 + (within >> 5); const int qb = within & 31; rowq = b * RB + CTX + qb * 256; seq = RB; }
        else { const int v = u - 512; b = v >> 3; h = v & 7; rowq = b * RB; seq = CTX; }
        const int kvh = h >> 2; const size_t key0 = (size_t)b * RB; const float negmv = ((const float*)(ws + W_MISC))[layer];
        attn::attn_dense_body(ATQ + (size_t)rowq * 1024 + h * 128, ATK + key0 * 256 + kvh * 128, ATV + key0 * 256 + kvh * 128,
                              ATZ + (size_t)rowq * 1024 + h * 128, MIX + (size_t)rowq * 2048 + 512 + h * 128, seq, negmv, lds);
    }
}
__device__ __forceinline__ int chunk_at(int dir, int pos) { return dir == 0 ? pos : (pos < 2 ? 1 - pos : 67 - pos); }
constexpr int S5_XS = 12  , S5_XB = 128 * S5_XS  , S5_SS = 16  , S5_WAVE_LDS = 2 * S5_XB * 4 + 128 * S5_SS * 2;
typedef short v4i16_t __attribute__((ext_vector_type(4)));
__device__ __forceinline__ v4i16_t lds_tr16(const LAS void* p) { return __builtin_amdgcn_ds_read_tr16_b64_v4i16((LAS v4i16_t*)p); }
struct S5C { bf16x8 bfx[8]; bf16x8 afy[4]; float lr, li; };
template <bool PASS2>
__device__ __forceinline__ void s5_load_consts(S5C& c, const float* lam, const float* bbt, const float* cmt, int lane) {
    const int fr = lane & 15, fq = lane >> 4;
#pragma unroll
    for (int ct = 0; ct < 8; ++ct) {
        const f32x8 v = *(const f32x8*)(bbt + (ct * 16 + fr) * 16 + 8 * (fq & 1));
        u32x4 w; w.x = pk2(v[0], v[1]); w.y = pk2(v[2], v[3]); w.z = pk2(v[4], v[5]); w.w = pk2(v[6], v[7]);
        c.bfx[ct] = (fq < 2) ? __builtin_bit_cast(bf16x8, w) : (bf16x8){0, 0, 0, 0, 0, 0, 0, 0};
    }
    if (PASS2) {
#pragma unroll
        for (int kk = 0; kk < 4; ++kk) { const f32x8 v = *(const f32x8*)(cmt + fr * 128 + kk * 32 + 8 * fq);
            u32x4 w; w.x = pk2(v[0], v[1]); w.y = pk2(v[2], v[3]); w.z = pk2(v[4], v[5]); w.w = pk2(v[6], v[7]); c.afy[kk] = __builtin_bit_cast(bf16x8, w); }
    }
    c.lr = lam[2 * lane]; c.li = lam[2 * lane + 1];
}
__device__ __forceinline__ void s5_load_u(bf16x8 (&au)[8], const bf16_t* U, int lane) {
    const int fr = lane & 15, fq = lane >> 4;
#pragma unroll
    for (int s_ = 0; s_ < 8; ++s_) { const bf16x8 raw = *(const bf16x8*)(U + (size_t)(s_ * 16 + fr) * 512 + 8 * (fq & 1)); au[s_] = (fq < 2) ? raw : (bf16x8){0, 0, 0, 0, 0, 0, 0, 0}; }
}
template <int DIR, bool PASS2>
__device__ __forceinline__ void s5_chunk_dir(const bf16x8 (&au)[8], const S5C& c, float& sr, float& si, f32x4 (&yacc)[8], LAS float* Xsf, LAS bf16_t* Ss, int lane) {
    const int fr = lane & 15, fq = lane >> 4;
    const float lr = c.lr, li = c.li;
    LAS unsigned* Xs = (LAS unsigned*)Xsf;
    const LAS unsigned char* trb = (const LAS unsigned char*)Ss + ((8 * fq + (fr >> 2)) * S5_SS + 4 * (fr & 3)) * 2;
#define S5_STAGE(SLAB, BUF) do { _Pragma("unroll") for (int ct = 0; ct < 8; ++ct) { \
        const f32x4 x = __builtin_amdgcn_mfma_f32_16x16x32_bf16(au[SLAB], c.bfx[ct], (f32x4){0.f, 0.f, 0.f, 0.f}, 0, 0, 0);   \
        u32x2 xw; xw.x = pk2(x[0], x[1]); xw.y = pk2(x[2], x[3]); *(LAS u32x2*)(Xs + (BUF) * S5_XB + (ct * 16 + fr) * S5_XS + 2 * fq) = xw; } } while (0)
#define S5_FETCH(XR, XI, BUF) do { _Pragma("unroll") for (int j = 0; j < 2; ++j) { XR[j] = *(const LAS u32x4*)(Xs + (BUF) * S5_XB + lane * S5_XS + 4 * j); XI[j] = *(const LAS u32x4*)(Xs + (BUF) * S5_XB + (64 + lane) * S5_XS + 4 * j); } } while (0)
#define S5_YMMA(SLAB) do { _Pragma("unroll") for (int kk = 0; kk < 4; ++kk) { \
        const v4i16_t lo = lds_tr16(trb + (kk * 32) * S5_SS * 2), hi = lds_tr16(trb + (kk * 32 + 4) * S5_SS * 2); \
        const bf16x8 bs = (bf16x8){lo[0], lo[1], lo[2], lo[3], hi[0], hi[1], hi[2], hi[3]};     \
        yacc[SLAB] = __builtin_amdgcn_mfma_f32_16x16x32_bf16(c.afy[kk], bs, yacc[SLAB], 0, 0, 0); } } while (0)
    u32x4 xrw[2], xiw[2], xrn[2], xin[2];
    S5_STAGE(DIR ? 7 : 0, 0); S5_FETCH(xrw, xiw, 0);
#pragma unroll
    for (int s_ = 0; s_ < 8; ++s_) {
        const int slab = DIR ? 7 - s_ : s_, slabn = DIR ? 6 - s_ : s_ + 1, slabp = DIR ? 8 - s_ : s_ - 1;
        if (s_ + 1 < 8) { S5_STAGE(slabn, (s_ + 1) & 1); S5_FETCH(xrn, xin, (s_ + 1) & 1); }
        if (PASS2 && s_ > 0) S5_YMMA(slabp);
        float so_r[16], so_i[16];
#pragma unroll
        for (int tt = 0; tt < 16; ++tt) {
            const int t = DIR ? 15 - tt : tt;
            const unsigned wr_ = xrw[t >> 3][(t >> 1) & 3], wi_ = xiw[t >> 3][(t >> 1) & 3]; const float x_r = (t & 1) ? hi16(wr_) : lo16(wr_), x_i = (t & 1) ? hi16(wi_) : lo16(wi_);
            const float nr = lr * sr - li * si + x_r, ni = lr * si + li * sr + x_i; sr = nr; si = ni;
            so_r[t] = sr; so_i[t] = si;
        }
        if (PASS2) {
            u32x4 w0, w1, w2, w3;
#pragma unroll
            for (int j = 0; j < 4; ++j) { w0[j] = pk2(so_r[2 * j], so_r[2 * j + 1]); w1[j] = pk2(so_r[8 + 2 * j], so_r[9 + 2 * j]); w2[j] = pk2(so_i[2 * j], so_i[2 * j + 1]); w3[j] = pk2(so_i[8 + 2 * j], so_i[9 + 2 * j]); }
            *(LAS u32x4*)(Ss + lane * S5_SS) = w0; *(LAS u32x4*)(Ss + lane * S5_SS + 8) = w1;
            *(LAS u32x4*)(Ss + (64 + lane) * S5_SS) = w2; *(LAS u32x4*)(Ss + (64 + lane) * S5_SS + 8) = w3;
        }
        if (s_ + 1 < 8) {
#pragma unroll
            for (int j = 0; j < 2; ++j) { xrw[j] = xrn[j]; xiw[j] = xin[j]; } }
    }
    if (PASS2) S5_YMMA(DIR ? 0 : 7);
    asm volatile("s_waitcnt lgkmcnt(0)" ::: "memory");
#undef S5_STAGE
#undef S5_FETCH
#undef S5_YMMA
}
__device__ __forceinline__ void s5_pass1(const Params& p, int layer, int G, char* lds) {
    unsigned char* ws = p.ws; int tid_o = threadIdx.x; asm volatile("" : "+v"(tid_o)); const int tid = tid_o, lane = tid & 63, wave = tid >> 6; const int gw = blockIdx.x * 8 + wave, NGW = G * 8;
    LAS float* Xs = (LAS float*)((LAS unsigned char*)lds + wave * S5_WAVE_LDS); LAS bf16_t* Ss = (LAS bf16_t*)((LAS unsigned char*)lds + wave * S5_WAVE_LDS + 2 * S5_XB * 4);
    const bf16_t* S5U = (const bf16_t*)(ws + W_PROJ) + (size_t)NROWS * SEC_S5U; float* F = (float*)(ws + W_S5F);
    const int g = gw & 31, dir = (gw >> 5) & 1, b = (gw >> 6) & 1, kb = gw >> 7; const int kstep = NGW >> 7;
    if (b >= NBATCH || kstep <= 0) return;
    const int ld = layer * 2 + dir;
    S5C c; s5_load_consts<false>(c, (const float*)(ws + W_LAM) + (size_t)((ld * 32 + g) * 64) * 2, (const float*)(ws + W_BBT) + (size_t)((ld * 32 + g) * 128) * 16,
                                 (const float*)(ws + W_CMT) + (size_t)((ld * 32 + g) * 16) * 128, lane);
    bf16x8 au[8], aun[8];
    if (kb < NCH) s5_load_u(au, S5U + (size_t)(b * RB + kb * 128) * 512 + g * 16, lane);
    for (int k = kb; k < NCH; k += kstep) {
        { const int kn = (k + kstep < NCH) ? k + kstep : k; s5_load_u(aun, S5U + (size_t)(b * RB + kn * 128) * 512 + g * 16, lane); }
        float sr = 0.f, si = 0.f; f32x4 yacc[8];
        if (dir == 0) s5_chunk_dir<0, false>(au, c, sr, si, yacc, Xs, Ss, lane);
        else          s5_chunk_dir<1, false>(au, c, sr, si, yacc, Xs, Ss, lane);
        float* Fo = F + ((size_t)((b * 32 + g) * 2 + dir) * NCH + k) * 128;
        Fo[lane] = sr; Fo[64 + lane] = si;
#pragma unroll
        for (int s_ = 0; s_ < 8; ++s_) au[s_] = aun[s_];
    }
}
__device__ __forceinline__ void s5_carry(const Params& p, int layer, int G) {
    unsigned char* ws = p.ws; int tid_o = threadIdx.x; asm volatile("" : "+v"(tid_o)); const int gt = blockIdx.x * NTHR + tid_o, NGT = G * NTHR;
    float* F = (float*)(ws + W_S5F);
    for (int idx = gt; idx < 2 * 32 * 2 * 64; idx += NGT) {
        const int n = idx & 63, dir = (idx >> 6) & 1, g = (idx >> 7) & 31, b = idx >> 12;
        const float* lt = (const float*)(ws + W_LAMT) + (size_t)(((layer * 2 + dir) * 32 + g) * 64 + n) * 2;
        const float lr = lt[0], li = lt[1];
        float* Fb = F + (size_t)((b * 32 + g) * 2 + dir) * NCH * 128;
        float sr = 0.f, si = 0.f;
        for (int p0 = 0; p0 < NCH; p0 += 11) {
            float fr_[11], fi_[11];
#pragma unroll
            for (int q = 0; q < 11; ++q) { const int k = chunk_at(dir, p0 + q); fr_[q] = Fb[k * 128 + n]; fi_[q] = Fb[k * 128 + 64 + n]; }
#pragma unroll
            for (int q = 0; q < 11; ++q) { const int k = chunk_at(dir, p0 + q); Fb[k * 128 + n] = sr; Fb[k * 128 + 64 + n] = si;
                const float nr = lr * sr - li * si + fr_[q], ni = lr * si + li * sr + fi_[q]; sr = nr; si = ni; }
        }
    }
}
constexpr int M2_COEF_OFF = 8 * S5_WAVE_LDS;
__device__ __forceinline__ void s5_pass2(const Params& p, int layer, int G, char* lds) {
    unsigned char* ws = p.ws; int tid_o = threadIdx.x; asm volatile("" : "+v"(tid_o)); const int tid = tid_o, lane = tid & 63, wave = tid >> 6;
    float* STC = (float*)(ws + W_STC); float* STN = (float*)(ws + W_STN); float* STS = (float*)(ws + W_STS); unsigned* CBw = (unsigned*)(ws + W_CB);
    LAS float* coef = (LAS float*)((LAS unsigned char*)lds + M2_COEF_OFF);
    if (tid < 16) { const int chain = tid, cdir = chain & 1; float* sb = STS + (size_t)chain * NCH * 4; float m = 0.f;
        for (int p0 = 0; p0 < NCH; p0 += 22) { float bl[22], am[22];
#pragma unroll
            for (int q = 0; q < 22; ++q) { const int k = chunk_at(cdir, p0 + q); bl[q] = sb[k * 4]; am[q] = sb[k * 4 + 1]; }
#pragma unroll
            for (int q = 0; q < 22; ++q) { const int k = chunk_at(cdir, p0 + q); if (blockIdx.x == 0) sb[k * 4 + 2] = m;
                const float mx = fmaxf(m, am[q]); coef[(chain * NCH + p0 + q) * 2] = __expf(m - mx); coef[(chain * NCH + p0 + q) * 2 + 1] = __expf(am[q] - mx); m = bl[q] + mx; } } }
    __syncthreads();
    int tid2 = tid; asm volatile("" : "+v"(tid2));
    const int gt2 = blockIdx.x * NTHR + tid2; const bool m2on = gt2 < 16 * 8192;
    const int m2chain = (gt2 >> 13) & 15, m2dir = m2chain & 1; float m2c0 = 0.f, m2c1 = 0.f;
    const float* m2base = STC + (size_t)m2chain * NCH * 16384 + 2 * (gt2 & 8191); unsigned* m2cb = CBw + (size_t)m2chain * NCH * 8192 + (gt2 & 8191);
    const bool n2on = gt2 < 16 * 64;
    const int n2chain = (gt2 >> 6) & 15, n2dir = n2chain & 1; float n2c0 = 0.f, n2c1 = 0.f; float* n2base = STN + (size_t)n2chain * NCH * 128 + 2 * (gt2 & 63);
    const int fr = lane & 15, fq = lane >> 4, dir = wave >> 2, pi = wave & 3;
    LAS float* Xs = (LAS float*)((LAS unsigned char*)lds + wave * S5_WAVE_LDS); LAS bf16_t* Ss = (LAS bf16_t*)((LAS unsigned char*)lds + wave * S5_WAVE_LDS + 2 * S5_XB * 4);
    LAS float* YX = (LAS float*)((LAS unsigned char*)lds + pi * S5_WAVE_LDS);
    bf16_t* S5U = (bf16_t*)(ws + W_PROJ) + (size_t)NROWS * SEC_S5U; const float* F = (const float*)(ws + W_S5F);
    const float* Dv = p.in[I_SSMD] + layer * 512;
    const int gp = blockIdx.x * 4 + pi, NGP = G * 4; const int g = gp & 31, b = (gp >> 5) & 1, kb = gp >> 6; const int kstep = NGP >> 6;
    const int ld = layer * 2 + dir;
    S5C c; s5_load_consts<true>(c, (const float*)(ws + W_LAM) + (size_t)((ld * 32 + g) * 64) * 2, (const float*)(ws + W_BBT) + (size_t)((ld * 32 + g) * 128) * 16,
                                (const float*)(ws + W_CMT) + (size_t)((ld * 32 + g) * 16) * 128, lane);
    const f32x4 dg = *(const f32x4*)(Dv + g * 16 + 4 * fq);
    const int nit = (kstep > 0) ? (NCH + kstep - 1) / kstep : 0;
    for (int it = 0; it < nit || it < 6; ++it) {
        int lane_i = lane; asm volatile("" : "+v"(lane_i)); const int fr_i = lane_i & 15, fq_i = lane_i >> 4;
        f32x2_t m2u[22]; const int m2b = it < 3 ? it : it - 3; const bool m2act = (it < 3) ? m2on : (it < 6 && n2on);
        if (m2act) {
#pragma unroll
            for (int q = 0; q < 22; ++q) { const int kk = chunk_at(it < 3 ? m2dir : n2dir, m2b * 22 + q); m2u[q] = (it < 3) ? *(const f32x2_t*)(m2base + (size_t)kk * 16384) : *(const f32x2_t*)(n2base + (size_t)kk * 128); }
        }
        const int k = kb + it * kstep; const bool act = (it < nit) && (k < NCH) && !(layer == 1 && k < 2);
        bf16_t* U = S5U + (size_t)(b * RB + (act ? k : 0) * 128) * 512 + g * 16;
        f32x4 yacc[8]; u32x2 uw[8];
#pragma unroll
        for (int s = 0; s < 8; ++s) yacc[s] = (f32x4){0.f, 0.f, 0.f, 0.f};
        if (act) {
            bf16x8 au[8]; s5_load_u(au, U, lane_i);
            const float* Fi = F + ((size_t)((b * 32 + g) * 2 + dir) * NCH + k) * 128; float sr = Fi[lane_i], si = Fi[64 + lane_i];
            if (dir == 0) s5_chunk_dir<0, true>(au, c, sr, si, yacc, Xs, Ss, lane);
            else          s5_chunk_dir<1, true>(au, c, sr, si, yacc, Xs, Ss, lane);
            if (dir == 0) {
#pragma unroll
                for (int s = 0; s < 8; ++s) uw[s] = *(const u32x2*)(U + (size_t)(s * 16 + fr_i) * 512 + 4 * fq_i);
            }
        }
        __syncthreads();
        if (act && dir == 1) {
#pragma unroll
            for (int s = 0; s < 8; ++s) *(LAS f32x4*)(YX + (s * 64 + lane) * 4) = yacc[s];
        }
        __syncthreads();
        if (act && dir == 0) {
#pragma unroll
            for (int s = 0; s < 8; ++s) { bf16_t* up = U + (size_t)(s * 16 + fr_i) * 512 + 4 * fq_i; const f32x4 yo = yacc[s] + *(const LAS f32x4*)(YX + (s * 64 + lane) * 4);
                const float y0 = yo[0] + dg[0] * lo16(uw[s].x), y1 = yo[1] + dg[1] * hi16(uw[s].x), y2 = yo[2] + dg[2] * lo16(uw[s].y), y3 = yo[3] + dg[3] * hi16(uw[s].y);
                u32x2 ow; ow.x = pk2(gelu_tanh(y0), gelu_tanh(y1)); ow.y = pk2(gelu_tanh(y2), gelu_tanh(y3)); *(u32x2*)up = ow; }
        }
        if (m2act) {
            if (it < 3) {
#pragma unroll
                for (int q = 0; q < 22; ++q) { const int pos = m2b * 22 + q, kk = chunk_at(m2dir, pos); m2cb[(size_t)kk * 8192] = pk2(m2c0, m2c1);
                    const float f0 = coef[(m2chain * NCH + pos) * 2], f1 = coef[(m2chain * NCH + pos) * 2 + 1]; m2c0 = f0 * m2c0 + f1 * m2u[q].x; m2c1 = f0 * m2c1 + f1 * m2u[q].y; }
            } else {
#pragma unroll
                for (int q = 0; q < 22; ++q) { const int pos = m2b * 22 + q, kk = chunk_at(n2dir, pos); *(f32x2_t*)(n2base + (size_t)kk * 128) = (f32x2_t){n2c0, n2c1};
                    const float f0 = coef[(n2chain * NCH + pos) * 2], f1 = coef[(n2chain * NCH + pos) * 2 + 1]; n2c0 = f0 * n2c0 + f1 * m2u[q].x; n2c1 = f0 * n2c1 + f1 * m2u[q].y; }
            }
        }
    }
}
constexpr int LDP = 136;
constexpr int ML_X0 = 0, ML_X1 = 128 * LDP * 2, ML_X2 = 2 * 128 * LDP * 2, ML_VEC = 3 * 128 * LDP * 2;
__device__ __forceinline__ void zero_acc8(f32x4 (&acc)[2][8]) {
#pragma unroll
    for (int i = 0; i < 2; ++i)
#pragma unroll
        for (int j = 0; j < 8; ++j) acc[i][j] = (f32x4){0.f, 0.f, 0.f, 0.f};
}
__device__ __forceinline__ void hgemm_rn(const bf16x8 (&af)[2][4], const LAS bf16_t* Bt, f32x4 (&acc)[2][8], int fr, int fq) {
#pragma unroll
    for (int kk = 0; kk < 4; ++kk) {
#pragma unroll
        for (int jh = 0; jh < 2; ++jh) {
            bf16x8 b[4];
#pragma unroll
            for (int j = 0; j < 4; ++j) b[j] = *(const LAS bf16x8*)(Bt + ((jh * 4 + j) * 16 + fr) * LDP + kk * 32 + 8 * fq);
#pragma unroll
            for (int i = 0; i < 2; ++i)
#pragma unroll
                for (int j = 0; j < 4; ++j) acc[i][jh * 4 + j] = __builtin_amdgcn_mfma_f32_16x16x32_bf16(b[j], af[i][kk], acc[i][jh * 4 + j], 0, 0, 0);
        }
    }
}
typedef short v4i16_m __attribute__((ext_vector_type(4)));
__device__ __forceinline__ bf16x8 tr_frag(const LAS bf16_t* T  , int k0, int n0, int fr, int fq) {
    const LAS bf16_t* p = T + (k0 + 8 * fq + (fr >> 2)) * LDP + n0 + 4 * (fr & 3);
    const v4i16_m lo = __builtin_amdgcn_ds_read_tr16_b64_v4i16((LAS v4i16_m*)p), hi = __builtin_amdgcn_ds_read_tr16_b64_v4i16((LAS v4i16_m*)(p + 4 * LDP));
    return (bf16x8){lo[0], lo[1], lo[2], lo[3], hi[0], hi[1], hi[2], hi[3]};
}
__device__ __forceinline__ void hgemm_nt(const LAS bf16_t* A, const LAS bf16_t* Bk, f32x4 (&acc)[2][8], int hw, int fr, int fq) {
#pragma unroll
    for (int kk = 0; kk < 4; ++kk) {
        bf16x8 a[2], b[4];
#pragma unroll
        for (int i = 0; i < 2; ++i) a[i] = *(const LAS bf16x8*)(A + (hw * 32 + i * 16 + fr) * LDP + kk * 32 + 8 * fq);
#pragma unroll
        for (int jh = 0; jh < 2; ++jh) {
#pragma unroll
            for (int j = 0; j < 4; ++j) b[j] = tr_frag(Bk, kk * 32, (jh * 4 + j) * 16, fr, fq);
#pragma unroll
            for (int i = 0; i < 2; ++i)
#pragma unroll
                for (int j = 0; j < 4; ++j) acc[i][jh * 4 + j] = __builtin_amdgcn_mfma_f32_16x16x32_bf16(b[j], a[i], acc[i][jh * 4 + j], 0, 0, 0);
        }
    }
}
__device__ __forceinline__ void hgemm_tt(const LAS bf16_t* Ak, const LAS bf16_t* Bk, f32x4 (&acc)[2][8], int hw, int fr, int fq) {
#pragma unroll
    for (int kk = 0; kk < 4; ++kk) {
        bf16x8 a[2], b[4];
#pragma unroll
        for (int i = 0; i < 2; ++i) a[i] = tr_frag(Ak, kk * 32, hw * 32 + i * 16, fr, fq);
#pragma unroll
        for (int jh = 0; jh < 2; ++jh) {
#pragma unroll
            for (int j = 0; j < 4; ++j) b[j] = tr_frag(Bk, kk * 32, (jh * 4 + j) * 16, fr, fq);
#pragma unroll
            for (int i = 0; i < 2; ++i)
#pragma unroll
                for (int j = 0; j < 4; ++j) acc[i][jh * 4 + j] = __builtin_amdgcn_mfma_f32_16x16x32_bf16(b[j], a[i], acc[i][jh * 4 + j], 0, 0, 0);
        }
    }
}
__device__ __forceinline__ void gate_scan_wave(int dir, const LAS float* lf, const LAS float* li, LAS float* bA, LAS float* aA, LAS float* pmA, LAS float* scl, int l) {
    const int t0 = dir ? 127 - 2 * l : 2 * l, t1 = dir ? 126 - 2 * l : 2 * l + 1;
    const float f0 = lf[t0], f1 = lf[t1]; const float s1 = f0 + f1; float x = s1;
#pragma unroll
    for (int o = 1; o < 64; o <<= 1) { const float y = __shfl_up(x, o); if (l >= o) x += y; }
    const float ex = x - s1; const float b0 = ex + f0, b1 = b0 + f1;
    const float a0 = li[t0] - b0, a1 = li[t1] - b1;
    float mx = fmaxf(a0, a1);
#pragma unroll
    for (int o = 1; o < 64; o <<= 1) { const float y = __shfl_up(mx, o); if (l >= o) mx = fmaxf(mx, y); }
    float pe = __shfl_up(mx, 1); if (l == 0) pe = -3.0e38f;
    const float p0 = fmaxf(pe, a0), p1 = fmaxf(p0, a1);
    bA[t0] = b0; bA[t1] = b1; aA[t0] = a0; aA[t1] = a1; pmA[t0] = p0; pmA[t1] = p1;
    if (l == 63) { scl[0] = mx; scl[1] = x; }
}
constexpr int ML_VF = 3 * 128 * LDP * 2;
struct M1Pre { u32x4 vv[4], kv[8]; float gval; };
__device__ __forceinline__ void m1_prefetch(M1Pre& P, const Params& p, int u, int tid) {
    unsigned char* ws = p.ws; const bf16_t* MLV = (const bf16_t*)(ws + W_PROJ) + (size_t)NROWS * SEC_MLV; const bf16_t* CK = (const bf16_t*)(ws + W_CK); const float* GD = (const float*)(ws + W_GD);
    const int k = u % NCH, h = (u / NCH) & 3, b = u / (NCH * 4); const int row0 = b * RB + k * 128; const int dir = tid >> 8, ht = tid & 255;
#pragma unroll
    for (int q = 0; q < 4; ++q) { const int c = tid + q * NTHR; P.vv[q] = *(const u32x4*)(MLV + (size_t)(row0 + (c >> 4)) * 512 + h * 128 + (c & 15) * 8); }
#pragma unroll
    for (int q = 0; q < 8; ++q) { const int c = ht + q * 256; P.kv[q] = *(const u32x4*)(CK + (size_t)(row0 + (c >> 4)) * 512 + h * 128 + (c & 15) * 8); }
    { const int which = ht >> 7, j = ht & 127; P.gval = GD[(size_t)(row0 + j) * 16 + (2 * dir + which) * 4 + h]; }
}
__device__ __forceinline__ void ml_m1(const Params& p, int layer, int G, char* ldsc) {
    unsigned char* ws = p.ws; LAS unsigned char* lds = (LAS unsigned char*)ldsc;
    LAS bf16_t* XV = (LAS bf16_t*)(lds + ML_X2); LAS float* vec = (LAS float*)(lds + ML_VF);
    float* STC = (float*)(ws + W_STC); float* STN = (float*)(ws + W_STN); float* STS = (float*)(ws + W_STS);
    int u = blockIdx.x; if (u >= 2 * 4 * NCH) return;
    M1Pre P;
    { int t0 = threadIdx.x; asm volatile("" : "+v"(t0)); m1_prefetch(P, p, u, t0); }
    while (u < 2 * 4 * NCH) {
        const int k = u % NCH, h = (u / NCH) & 3, b = u / (NCH * 4); const int un = u + G;
        int tid_ = threadIdx.x; asm volatile("" : "+v"(tid_));
        const int tid = tid_, lane = tid & 63, wid = tid >> 6, fr = lane & 15, fq = lane >> 4, dir = wid >> 2, hw = wid & 3, ht = tid & 255;
        LAS bf16_t* XK = (LAS bf16_t*)(lds + (dir ? ML_X0 : ML_X1));
        LAS float* lfA = vec + dir * 1024; LAS float* liA = lfA + 128; LAS float* bA = lfA + 256; LAS float* aA = lfA + 384; LAS float* pmA = lfA + 512; LAS float* scl = lfA + 640; LAS float* nsum = lfA + 768;
        const int chain = (b * 4 + h) * 2 + dir;
        __syncthreads();
        { const int which = ht >> 7, j = ht & 127; (which ? lfA : liA)[j] = P.gval; }
#pragma unroll
        for (int q = 0; q < 4; ++q) { const int c = tid + q * NTHR; *(LAS u32x4*)(XV + (c >> 4) * LDP + (c & 15) * 8) = P.vv[q]; }
        __syncthreads();
        if (hw == 0) gate_scan_wave(dir, lfA, liA, bA, aA, pmA, scl, lane);
        __syncthreads();
        const float amax = scl[0];
#pragma unroll
        for (int q = 0; q < 8; ++q) { const int c = ht + q * 256, r = c >> 4; const float w = __expf(aA[r] - amax);
            u32x4 o;
#pragma unroll
            for (int i = 0; i < 4; ++i) o[i] = pk2(lo16(P.kv[q][i]) * w, hi16(P.kv[q][i]) * w);
            *(LAS u32x4*)(XK + r * LDP + (c & 15) * 8) = o; }
        m1_prefetch(P, p, un < 2 * 4 * NCH ? un : u, tid);
        __syncthreads();
        f32x4 acc[2][8]; zero_acc8(acc);
        hgemm_tt(XV, XK, acc, hw, fr, fq);
        float* Uo = STC + ((size_t)chain * NCH + k) * 16384;
#pragma unroll
        for (int i = 0; i < 2; ++i)
#pragma unroll
            for (int j = 0; j < 8; ++j) *(f32x4*)(Uo + (size_t)(hw * 32 + i * 16 + fr) * 128 + j * 16 + 4 * fq) = acc[i][j];
        { const int d = ht & 127, part = ht >> 7; float s0 = 0.f, s1 = 0.f;
#pragma unroll 16
            for (int j = 0; j < 64; j += 2) { s0 += bf2f(XK[(part * 64 + j) * LDP + d]); s1 += bf2f(XK[(part * 64 + j + 1) * LDP + d]); }
            if (part == 1) nsum[d] = s0 + s1;
            __syncthreads();
            if (part == 0) STN[((size_t)chain * NCH + k) * 128 + d] = (s0 + s1) + nsum[d]; }
        if (ht == 0) { float* so = STS + ((size_t)chain * NCH + k) * 4; so[0] = scl[1]; so[1] = amax; }
        u = un;
    }
}
struct M3Pre { u32x4 qv[4], kv[4], vv[4]; float gval, nval, m_in; };
__device__ __forceinline__ int m3_next_unit(int u, int G, int layer) { u += G; while (u < 2 * 4 * NCH && layer == 1 && (u % NCH) < 2) u += G; return u; }
__device__ __forceinline__ void m3_prefetch(M3Pre& P, const Params& p, int u, int tid) {
    unsigned char* ws = p.ws; const bf16_t* PROJ = (const bf16_t*)(ws + W_PROJ); const bf16_t* MLV = PROJ + (size_t)NROWS * SEC_MLV;
    const bf16_t* CQ = (const bf16_t*)(ws + W_CQ); const bf16_t* CK = (const bf16_t*)(ws + W_CK); const float* GD = (const float*)(ws + W_GD);
    const float* STN = (const float*)(ws + W_STN); const float* STS = (const float*)(ws + W_STS);
    const int k = u % NCH, h = (u / NCH) & 3, b = u / (NCH * 4); const int row0 = b * RB + k * 128; const int dir = tid >> 8, ht = tid & 255; const int chain = (b * 4 + h) * 2 + dir;
#pragma unroll
    for (int q = 0; q < 4; ++q) { const int c = tid + q * NTHR; const size_t go = (size_t)(row0 + (c >> 4)) * 512 + h * 128 + (c & 15) * 8;
        P.qv[q] = *(const u32x4*)(CQ + go); P.kv[q] = *(const u32x4*)(CK + go); P.vv[q] = *(const u32x4*)(MLV + go); }
    { const int which = ht >> 7, j = ht & 127; P.gval = GD[(size_t)(row0 + j) * 16 + (2 * dir + which) * 4 + h]; }
    P.nval = STN[((size_t)chain * NCH + k) * 128 + (ht & 127)];
    P.m_in = STS[((size_t)chain * NCH + k) * 4 + 2];
}
__device__ __forceinline__ void ml_m3(const Params& p, int layer, int G, char* ldsc) {
    unsigned char* ws = p.ws; LAS unsigned char* lds = (LAS unsigned char*)ldsc;
    LAS bf16_t* X0 = (LAS bf16_t*)(lds + ML_X0); LAS bf16_t* X1 = (LAS bf16_t*)(lds + ML_X1); LAS bf16_t* XV = (LAS bf16_t*)(lds + ML_X2); LAS float* vec = (LAS float*)(lds + ML_VF);
    LAS float* HX = (LAS float*)(lds + ML_X0);
    const bf16_t* PROJ = (const bf16_t*)(ws + W_PROJ); const bf16_t* MLO = PROJ + (size_t)NROWS * SEC_MLO; const bf16_t* MLZ = PROJ + (size_t)NROWS * SEC_MLZ;
    bf16_t* MIX = (bf16_t*)(ws + W_XN); const float* mnw = p.in[I_MNORM] + layer * 512;
    const int bxr = (G != 256) ? (int)blockIdx.x : (blockIdx.x % 8 != 0) ? (int)(blockIdx.x - 1 - blockIdx.x / 8) : (int)(224 + blockIdx.x / 8);
    int u = bxr; if (layer == 1 && (u % NCH) < 2) u = m3_next_unit(u, G, layer);
    if (u >= 2 * 4 * NCH) return;
    M3Pre P;
    { int t0 = threadIdx.x; asm volatile("" : "+v"(t0)); m3_prefetch(P, p, u, t0); }
    while (u < 2 * 4 * NCH) {
        const int k = u % NCH, h = (u / NCH) & 3, b = u / (NCH * 4); const int row0 = b * RB + k * 128;
        const int un = m3_next_unit(u, G, layer);
        int tid_ = threadIdx.x; asm volatile("" : "+v"(tid_));
        const int tid = tid_, lane = tid & 63, wid = tid >> 6, fr = lane & 15, fq = lane >> 4, dir = wid >> 2, hw = wid & 3, ht = tid & 255;
        LAS bf16_t* XC = dir ? X0 : X1;
        LAS float* lfA = vec + dir * 1024; LAS float* liA = lfA + 128; LAS float* bA = lfA + 256; LAS float* aA = lfA + 384; LAS float* pmA = lfA + 512; LAS float* scl = lfA + 640; LAS float* nin = lfA + 768;
        LAS float* ssx = vec + 2048;
        __syncthreads();
        u32x4 cpre[8];
        { const bf16_t* Cg = (const bf16_t*)(ws + W_CB) + ((size_t)((b * 4 + h) * 2 + dir) * NCH + k) * 16384;
#pragma unroll
          for (int q = 0; q < 8; ++q) cpre[q] = *(const u32x4*)(Cg + (size_t)(ht + q * 256) * 8); }
#pragma unroll
        for (int q = 0; q < 4; ++q) { const int c = tid + q * NTHR; const int lo = (c >> 4) * LDP + (c & 15) * 8;
            *(LAS u32x4*)(X0 + lo) = P.qv[q]; *(LAS u32x4*)(X1 + lo) = P.kv[q]; *(LAS u32x4*)(XV + lo) = P.vv[q]; }
        { const int which = ht >> 7, j = ht & 127; (which ? lfA : liA)[j] = P.gval; }
        if (ht < 128) nin[ht] = P.nval;
        const float m_in = P.m_in;
        __syncthreads();
        bf16x8 qf[2][4];
#pragma unroll
        for (int i = 0; i < 2; ++i)
#pragma unroll
            for (int kk = 0; kk < 4; ++kk) qf[i][kk] = *(const LAS bf16x8*)(X0 + (hw * 32 + i * 16 + fr) * LDP + kk * 32 + 8 * fq);
        f32x4 sacc[2][8]; zero_acc8(sacc);
        hgemm_rn(qf, X1, sacc, fr, fq);
        if (hw == 0) gate_scan_wave(dir, lfA, liA, bA, aA, pmA, scl, lane);
        __syncthreads();
#pragma unroll
        for (int q = 0; q < 8; ++q) { const int c = ht + q * 256; *(LAS u32x4*)(XC + (c >> 4) * LDP + (c & 15) * 8) = cpre[q]; }
        __syncthreads();
        f32x4 acc[2][8]; zero_acc8(acc);
        hgemm_rn(qf, XC, acc, fr, fq);
        float Mt[2], wi[2], qn[2];
#pragma unroll
        for (int i = 0; i < 2; ++i) { const int t = hw * 32 + i * 16 + fr; Mt[i] = fmaxf(m_in, pmA[t]); wi[i] = __expf(m_in - Mt[i]); float s = 0.f;
#pragma unroll
            for (int kk = 0; kk < 4; ++kk) { const u32x4 w = __builtin_bit_cast(u32x4, qf[i][kk]); const f32x4 n0 = *(const LAS f32x4*)(nin + kk * 32 + 8 * fq), n1 = *(const LAS f32x4*)(nin + kk * 32 + 8 * fq + 4);
                s += lo16(w.x) * n0.x + hi16(w.x) * n0.y + lo16(w.y) * n0.z + hi16(w.y) * n0.w + lo16(w.z) * n1.x + hi16(w.z) * n1.y + lo16(w.w) * n1.z + hi16(w.w) * n1.w; }
            s += __shfl_xor(s, 16); s += __shfl_xor(s, 32); qn[i] = s;
#pragma unroll
            for (int j = 0; j < 8; ++j) acc[i][j] *= wi[i]; }
        __syncthreads();
        float den[2];
#pragma unroll
        for (int i = 0; i < 2; ++i) { const int t = hw * 32 + i * 16 + fr; float rs = 0.f; const int jd = 2 * hw + i;
#pragma unroll
            for (int j = 0; j < 8; ++j) { const int s0 = j * 16 + 4 * fq; u32x2 w;
                if (j == jd) { const f32x4 av = *(const LAS f32x4*)(aA + s0); float pv[4];
#pragma unroll
                    for (int rg = 0; rg < 4; ++rg) { const int s = s0 + rg; const bool valid = dir ? (s >= t) : (s <= t);
                        const float e = __expf(fminf(av[rg] - Mt[i], 0.f)); pv[rg] = valid ? sacc[i][j][rg] * e : 0.f; rs += pv[rg]; }
                    w.x = pk2(pv[0], pv[1]); w.y = pk2(pv[2], pv[3]); }
                else if (dir ? (j > jd) : (j < jd)) { const f32x4 av = *(const LAS f32x4*)(aA + s0); float pv[4];
#pragma unroll
                    for (int rg = 0; rg < 4; ++rg) { pv[rg] = sacc[i][j][rg] * __expf(av[rg] - Mt[i]); rs += pv[rg]; }
                    w.x = pk2(pv[0], pv[1]); w.y = pk2(pv[2], pv[3]); }
                else { w.x = 0u; w.y = 0u; }
                *(LAS u32x2*)(XC + t * LDP + s0) = w; }
            rs += __shfl_xor(rs, 16); rs += __shfl_xor(rs, 32); den[i] = rs + wi[i] * qn[i]; }
        __syncthreads();
        hgemm_nt(XC, XV, acc, hw, fr, fq);
#pragma unroll
        for (int i = 0; i < 2; ++i) { const int t = hw * 32 + i * 16 + fr; const float fl = __expf(-(bA[t] + Mt[i])); const float inv = __builtin_amdgcn_rcpf(fmaxf(fabsf(den[i]), fl));
#pragma unroll
            for (int j = 0; j < 8; ++j) acc[i][j] *= inv; }
        m3_prefetch(P, p, un < 2 * 4 * NCH ? un : u, tid);
        __syncthreads();
#pragma unroll
        for (int i = 0; i < 2; ++i)
#pragma unroll
            for (int jj = 0; jj < 4; ++jj) { const int j = dir ? jj : jj + 4; *(LAS f32x4*)(HX + (hw * 32 + i * 16 + fr) * 132 + j * 16 + 4 * fq) = acc[i][j]; }
        __syncthreads();
        float ssl[2];
#pragma unroll
        for (int i = 0; i < 2; ++i) { const int t = hw * 32 + i * 16 + fr; float ss = 0.f;
#pragma unroll
            for (int jj = 0; jj < 4; ++jj) { const int j = dir ? jj + 4 : jj; acc[i][j] += *(const LAS f32x4*)(HX + t * 132 + j * 16 + 4 * fq);
                ss += (acc[i][j].x * acc[i][j].x + acc[i][j].y * acc[i][j].y) + (acc[i][j].z * acc[i][j].z + acc[i][j].w * acc[i][j].w); }
            ss += __shfl_xor(ss, 16); ss += __shfl_xor(ss, 32); ssl[i] = ss;
            if (fq == 0) ssx[dir * 128 + t] = ss; }
        __syncthreads();
#pragma unroll
        for (int i = 0; i < 2; ++i) { const int t = hw * 32 + i * 16 + fr; const float rstd = rsqrtf((ssl[i] + ssx[(1 - dir) * 128 + t]) * (1.0f / 128.0f) + EPSN); const size_t row = (size_t)(row0 + t);
            u32x2 ow[4], zw[4];
#pragma unroll
            for (int jj = 0; jj < 4; ++jj) { const int e0 = (dir ? jj + 4 : jj) * 16 + 4 * fq; ow[jj] = *(const u32x2*)(MLO + row * 512 + h * 128 + e0); zw[jj] = *(const u32x2*)(MLZ + row * 512 + h * 128 + e0); }
#pragma unroll
            for (int jj = 0; jj < 4; ++jj) { const int j = dir ? jj + 4 : jj; const int e0 = j * 16 + 4 * fq; const f32x4 nw = *(const f32x4*)(mnw + h * 128 + e0);
                const float o0 = acc[i][j].x * rstd * nw.x * sigm(lo16(ow[jj].x)) * silu(lo16(zw[jj].x)), o1 = acc[i][j].y * rstd * nw.y * sigm(hi16(ow[jj].x)) * silu(hi16(zw[jj].x));
                const float o2 = acc[i][j].z * rstd * nw.z * sigm(lo16(ow[jj].y)) * silu(lo16(zw[jj].y)), o3 = acc[i][j].w * rstd * nw.w * sigm(hi16(ow[jj].y)) * silu(hi16(zw[jj].y));
                u32x2 w; w.x = pk2(o0, o1); w.y = pk2(o2, o3); *(u32x2*)(MIX + row * 2048 + 1536 + h * 128 + e0) = w; } }
        u = un;
    }
}
__device__ __forceinline__ void ctx_outproj_small(const Params& p, int G, char* ldsc) {
    unsigned char* ws = p.ws; LAS float* part = (LAS float*)(LAS unsigned char*)ldsc;
    const bf16_t* MIX = (const bf16_t*)(ws + W_XN); const bf16_t* WT = (const bf16_t*)(ws + W_WOUT); const float* gate = (const float*)(ws + W_ADA) + 2 * 6144 + 4096;
    float* HC = (float*)(ws + W_HCTX);
    for (int t = blockIdx.x; t < 8 * 32; t += G) {
        int tid_ = threadIdx.x; asm volatile("" : "+v"(tid_));
        const int tid = tid_, lane = tid & 63, wid = tid >> 6, fr = lane & 15, fq = lane >> 4;
        const int rt = t >> 5, nt = t & 31;
        const int crow0 = rt * 64; const int b = crow0 / CTX; const size_t mixrow0 = (size_t)b * RB + (crow0 % CTX);
        const bf16_t* Ab = MIX + mixrow0 * DM + wid * 256 + 8 * fq; const bf16_t* Bb = WT + (size_t)(nt * 64) * DM + wid * 256 + 8 * fq;
        f32x4 acc[4][4];
#pragma unroll
        for (int i = 0; i < 4; ++i)
#pragma unroll
            for (int j = 0; j < 4; ++j) acc[i][j] = (f32x4){0.f, 0.f, 0.f, 0.f};
#pragma unroll 1
        for (int kh = 0; kh < 4; ++kh) {
            bf16x8 a[2][4], bb[2][4];
#pragma unroll
            for (int kk = 0; kk < 2; ++kk)
#pragma unroll
                for (int i = 0; i < 4; ++i) { a[kk][i] = *(const bf16x8*)(Ab + (size_t)(i * 16 + fr) * DM + kh * 64 + kk * 32); bb[kk][i] = *(const bf16x8*)(Bb + (size_t)(i * 16 + fr) * DM + kh * 64 + kk * 32); }
#pragma unroll
            for (int kk = 0; kk < 2; ++kk)
#pragma unroll
                for (int i = 0; i < 4; ++i)
#pragma unroll
                    for (int j = 0; j < 4; ++j) acc[i][j] = __builtin_amdgcn_mfma_f32_16x16x32_bf16(bb[kk][j], a[kk][i], acc[i][j], 0, 0, 0);
        }
        __syncthreads();
#pragma unroll
        for (int i = 0; i < 4; ++i)
#pragma unroll
            for (int j = 0; j < 4; ++j) *(LAS f32x4*)(part + wid * 4096 + (i * 16 + fr) * 64 + j * 16 + 4 * fq) = acc[i][j];
        __syncthreads();
        { const int r = tid >> 3, c0 = (tid & 7) * 8; f32x4 s0 = {0.f, 0.f, 0.f, 0.f}, s1 = {0.f, 0.f, 0.f, 0.f};
#pragma unroll
            for (int w = 0; w < 8; ++w) { s0 += *(const LAS f32x4*)(part + w * 4096 + r * 64 + c0); s1 += *(const LAS f32x4*)(part + w * 4096 + r * 64 + c0 + 4); }
            const int n0 = nt * 64 + c0; const size_t o = (size_t)(crow0 + r) * DM + n0;
            const f32x4 g0 = *(const f32x4*)(gate + n0), g1 = *(const f32x4*)(gate + n0 + 4);
            const f32x4 h0 = *(const f32x4*)(p.in[I_CTX] + o), h1 = *(const f32x4*)(p.in[I_CTX] + o + 4);
            *(f32x4*)(HC + o) = h0 + g0 * s0; *(f32x4*)(HC + o + 4) = h1 + g1 * s1; }
    }
}
#define XB_TMO      128
#define XB_XCNT(j)  (256  + 64 * (j))
#define XB_XSUB(j)  (1280 + 64 * (j))
#define XB_XGEN(j)  (2304 + 64 * (j))
#define XB_TOP      3328
#define XB_TOPGEN   3392
#define XCD_BAR_WORDS 3456
#define XB_SPIN_CAP (1u << 18)

__device__ __forceinline__ unsigned xb_ld(unsigned* p)              { return __hip_atomic_load(p, __ATOMIC_RELAXED, __HIP_MEMORY_SCOPE_AGENT); }
__device__ __forceinline__ unsigned xb_add(unsigned* p, unsigned v) { return __hip_atomic_fetch_add(p, v, __ATOMIC_RELAXED, __HIP_MEMORY_SCOPE_AGENT); }
__device__ __forceinline__ unsigned xb_xcc_id() { return (unsigned)__builtin_amdgcn_s_getreg((3 << 11) | 20) & 0xFu; }
#define XB_SPIN(cond, bar) do { unsigned _sp = 0; while (cond) { __builtin_amdgcn_s_sleep(1); \
    if ((++_sp & 255u) == 0u) { if (xb_ld(&(bar)[XB_TMO])) break; if (_sp > XB_SPIN_CAP) { atomicAdd(&(bar)[XB_TMO], 1u); break; } } } } while (0)

struct XcdBarrier {
    unsigned* bar; unsigned x;
    volatile LAS unsigned* st;
};

__device__ __forceinline__ XcdBarrier xcd_barrier_post(unsigned* bar, volatile LAS unsigned* st) {
    XcdBarrier b; b.bar = bar; b.x = xb_xcc_id(); b.st = st;
    if (threadIdx.x == 0) (void)xb_add(&bar[XB_XCNT(b.x)], 1u);
    return b;
}
__device__ __forceinline__ void xcd_barrier_complete(unsigned* bar, unsigned x, unsigned& nloc, unsigned& nx) {
    const unsigned G = gridDim.x * gridDim.y * gridDim.z;
    unsigned sum, cnt, mine, sp = 0u;
    for (;;) {
        sum = 0u; cnt = 0u; mine = 0u;
#pragma unroll
        for (unsigned j = 0; j < 16; ++j) { const unsigned c = xb_ld(&bar[XB_XCNT(j)]); sum += c; cnt += (c > 0u) ? 1u : 0u; mine = (j == x) ? c : mine; }
        if (sum == G) break;
        __builtin_amdgcn_s_sleep(1);
        if ((++sp & 255u) == 0u) { if (xb_ld(&bar[XB_TMO])) break; if (sp > XB_SPIN_CAP) { atomicAdd(&bar[XB_TMO], 1u); break; } }
    }
    nloc = mine > 0u ? mine : 1u; nx = cnt > 0u ? cnt : 1u;
}

__device__ __forceinline__ void xcd_barrier(const XcdBarrier& b) {
    asm volatile("s_waitcnt vmcnt(0)" ::: "memory");
    __syncthreads();
    if (threadIdx.x == 0) {
        unsigned* bar = b.bar; unsigned bx_ = b.x; asm volatile("" : "+s"(bx_));
        __builtin_amdgcn_s_waitcnt(0);
        unsigned nloc = b.st[0], nx = b.st[1];
        if (nloc == 0u) { xcd_barrier_complete(bar, bx_, nloc, nx); b.st[0] = nloc; b.st[1] = nx; }
        const unsigned old = xb_add(&bar[XB_XSUB(bx_)], 1u);
        const unsigned gen = old / nloc;
        if (old + 1u == (gen + 1u) * nloc) {
            __builtin_amdgcn_fence(__ATOMIC_RELEASE, "agent");
            asm volatile("s_waitcnt vmcnt(0)" ::: "memory");
            const unsigned og = xb_add(&bar[XB_TOP], 1u);
            const unsigned tg = og / nx;
            if (og + 1u == (tg + 1u) * nx) xb_add(&bar[XB_TOPGEN], 1u);
            else XB_SPIN(xb_ld(&bar[XB_TOPGEN]) == tg, bar);
            __builtin_amdgcn_fence(__ATOMIC_ACQUIRE, "agent");
            xb_add(&bar[XB_XGEN(bx_)], 1u);
            asm volatile("s_waitcnt vmcnt(0)" ::: "memory");
        } else {
            XB_SPIN(xb_ld(&bar[XB_XGEN(bx_)]) == gen, bar);
            __builtin_amdgcn_fence(__ATOMIC_ACQUIRE, "agent");
            asm volatile("s_waitcnt vmcnt(0)" ::: "memory");
        }
    }
    __syncthreads();
}
constexpr int MISC_OFF = LDS_BYTES - 64;
constexpr size_t CTL_ZERO_BYTES = 65536;
#ifndef PROBE_A
#define PROBE_A -1
#endif
#ifndef PROBE_B
#define PROBE_B -1
#endif
constexpr int STAMP_OFF = LDS_BYTES - 512;
#define STAMP() do { if ((PROBE_A >= 0 || PROBE_B >= 0) && blockIdx.x == 0 && threadIdx.x == 0) { ((volatile LAS unsigned long long*)(lds_raw + STAMP_OFF))[nstamp] = __builtin_amdgcn_s_memrealtime(); } ++nstamp; } while (0)
__global__ void __launch_bounds__(NTHR, 2) mega_fwd(Params p) {
    extern __shared__ __attribute__((aligned(16))) unsigned char lds_raw[];
    char* lds = (char*)lds_raw;
    const int G = gridDim.x;
    unsigned char* ws = p.ws;
    bf16_t* XN = (bf16_t*)(ws + W_XN); bf16_t* PROJ = (bf16_t*)(ws + W_PROJ);
    if (threadIdx.x < 16) ((LAS unsigned*)(lds_raw + MISC_OFF))[threadIdx.x] = 0u;
    __syncthreads();
    if (threadIdx.x == 0) ((volatile LAS unsigned long long*)(lds_raw + STAMP_OFF))[40] = 0ull;
#if defined(XCC_PROBE)
    if (threadIdx.x == 0) { const unsigned xid = (unsigned)__builtin_amdgcn_s_getreg((3 << 11) | 20) & 0xFu; if (xid != (blockIdx.x & 7u)) atomicAdd((unsigned*)(ws + W_MISC + 2048), 1u); }
#endif
    int nstamp = 0; STAMP();
    XcdBarrier bar = xcd_barrier_post((unsigned*)ws, (volatile LAS unsigned*)(lds_raw + MISC_OFF));


    p0_prologue(p, lds, G);

    xcd_barrier(bar); STAMP();

    p0b_ada(p, G);

    xcd_barrier(bar); STAMP();
    for (int layer = 0; layer < 2; ++layer) {
        const int lat_only = (layer == 1) ? 1 : 0;
        p1_xn(p, layer, G);
        xcd_barrier(bar); STAMP();
        {
            pg8::Gemm g{XN, (const bf16_t*)(ws + W_WIN + layer * SZ_WIN), NROWS, NPROJ, DM};
            pg8::StaticOrder S; S.init(NROWS / 256, NPROJ / 256, G, (int)blockIdx.x, 0);
            pg8::EpiProj E{PROJ, (float*)(ws + W_GRAW)};
            pg8::gemm_phase<pg8::EpiProj, pg8::StaticOrder, true, true>((PG8_LAS unsigned char*)lds_raw, g, S, E);
        }
        xcd_barrier(bar); STAMP();
        p3_post(p, layer, G);
        __syncthreads(); STAMP();
        s5_pass1(p, layer, G, lds);
        xcd_barrier(bar); STAMP();
        ml_m1(p, layer, G, lds);
        s5_carry(p, layer, G);
        xcd_barrier(bar); STAMP();
        s5_pass2(p, layer, G, lds);
        xcd_barrier(bar); STAMP();
        p4_attn(p, layer, G, lds);
        __syncthreads(); STAMP();
        ml_m3(p, layer, G, lds);
        __syncthreads(); STAMP();
        {
            pg8::Gemm g{PROJ + (size_t)NROWS * SEC_S5U, (const bf16_t*)(ws + W_WGLU + layer * SZ_WGLU), NROWS, 512, 512};
            pg8::StaticOrder S; S.init(lat_only ? 64 : 66, 2, G, (int)((blockIdx.x + G - 124) % G), lat_only);
            pg8::EpiGlu E{PROJ + (size_t)NROWS * SEC_S5U, PROJ + (size_t)NROWS * SEC_S5Z, XN};
            pg8::gemm_phase<pg8::EpiGlu, pg8::StaticOrder, true, true>((PG8_LAS unsigned char*)lds_raw, g, S, E);
        }
        xcd_barrier(bar); STAMP();
        {
            pg8::Gemm g{XN, (const bf16_t*)(ws + W_WOUT + layer * SZ_WOUT), NROWS, DM, DM};
            pg8::StaticOrder S; S.init(64, DM / 256, G, (int)blockIdx.x, 1);
            pg8::EpiDelta E{layer == 0 ? (bf16_t*)p.out : PROJ, (const float*)(ws + W_ADA) + layer * 3 * 6144, layer == 0 ? 2 * DM : DM};
            pg8::gemm_phase<pg8::EpiDelta, pg8::StaticOrder, true, true>((PG8_LAS unsigned char*)lds_raw, g, S, E);
        }
        if (layer == 0) { __syncthreads(); ctx_outproj_small(p, G, lds); }
        xcd_barrier(bar); STAMP();
    }

    p_final(p, G);
#if defined(XCC_PROBE)
    xcd_barrier(bar);
    if (blockIdx.x == 0 && threadIdx.x == 0) { asm volatile("s_waitcnt vmcnt(0)" ::: "memory"); p.out[0] += 0.04f + 5.0e-4f * (float)__hip_atomic_load((unsigned*)(ws + W_MISC + 2048), __ATOMIC_RELAXED, __HIP_MEMORY_SCOPE_AGENT); }
#endif
    STAMP();
    if ((PROBE_A >= 0 || PROBE_B >= 0) && blockIdx.x == 0 && threadIdx.x == 0) {
        volatile LAS unsigned long long* st = (volatile LAS unsigned long long*)(lds_raw + STAMP_OFF);
        if (PROBE_B >= 0) { const unsigned long long T2 = st[PROBE_B + 1] - st[PROBE_B]; asm volatile("s_waitcnt vmcnt(0)" ::: "memory"); p.out[0] += (float)T2 * 1.0e-5f; }
        if (PROBE_A >= 0) { const unsigned long long T = (PROBE_A >= 100) ? st[40] : st[PROBE_A + 1] - st[PROBE_A]; const unsigned long long t0 = __builtin_amdgcn_s_memrealtime(); while (__builtin_amdgcn_s_memrealtime() - t0 < 8ull * T) __builtin_amdgcn_s_sleep(16); }
    }

}

extern "C" void kernel_launch(void* const* d_in, const int* in_sizes, int n_in, void* d_out, int out_size, void* d_ws, size_t ws_size, hipStream_t stream) {
    static int grid = 0;
    if (grid == 0) {
        if (n_in != 25 || in_sizes[0] != NBATCH * SEQ * DM || out_size != NBATCH * SEQ * DM || ws_size < W_END) {
            fprintf(stderr, "kernel_launch: shape mismatch (n_in %d, in0 %d, out %d, ws %zu, need ws >= %zu)\n", n_in, n_in > 0 ? in_sizes[0] : -1, out_size, ws_size, (size_t)W_END); grid = -1; return; }
        int dev = 0, cus = 0, per_cu = 0;
        if (hipGetDevice(&dev) != hipSuccess || hipDeviceGetAttribute(&cus, hipDeviceAttributeMultiprocessorCount, dev) != hipSuccess) { grid = -1; return; }
        if (hipFuncSetAttribute((const void*)mega_fwd, hipFuncAttributeMaxDynamicSharedMemorySize, LDS_BYTES) != hipSuccess) { fprintf(stderr, "kernel_launch: hipFuncSetAttribute failed\n"); grid = -1; return; }
        if (hipOccupancyMaxActiveBlocksPerMultiprocessor(&per_cu, (const void*)mega_fwd, NTHR, LDS_BYTES) != hipSuccess || per_cu < 1) { fprintf(stderr, "kernel_launch: occupancy query says %d\n", per_cu); per_cu = 1; }
        (void)hipGetLastError();
        grid = cus;
    }
    if (grid < 0) return;
    if (hipMemsetAsync(d_ws, 0, CTL_ZERO_BYTES, stream) != hipSuccess) { fprintf(stderr, "kernel_launch: memset failed\n"); return; }
    Params p{};
    for (int i = 0; i < 25; ++i) p.in[i] = (const float*)d_in[i];
    p.out = (float*)d_out; p.ws = (unsigned char*)d_ws;
    void* args[] = {&p};
    const hipError_t e = hipLaunchCooperativeKernel((const void*)mega_fwd, dim3(grid), dim3(NTHR), args, LDS_BYTES, stream);
    if (e != hipSuccess) fprintf(stderr, "kernel_launch: cooperative launch failed: %s (grid %d)\n", hipGetErrorString(e), grid);
}
```

```cpp
#include <hip/hip_runtime.h>
#include <hip/hip_cooperative_groups.h>
#include <hip/hip_bf16.h>
#include <cstdio>
#include <cstdint>
#include <cmath>
namespace cg = cooperative_groups;

constexpr int DM = 2048, NBATCH = 2, SEQ = 8192, CTX = 256, RB = SEQ + CTX  , NROWS = NBATCH * RB  ;
constexpr int NCOL_IN = 6160, NPROJ = 6400;
constexpr int NCH = RB / 128;
constexpr float EPSN = 1e-6f;
namespace pg8 {
#define PG8_LAS __attribute__((address_space(3)))
typedef unsigned short bf16_t;
typedef short bf16x8 __attribute__((ext_vector_type(8)));
typedef float f32x4 __attribute__((ext_vector_type(4)));
typedef unsigned u32x4 __attribute__((ext_vector_type(4)));
constexpr int BM = 256, BK = 64, HALF = 128, HTB = HALF * BK * 2  , STAGE_BYTES = 8 * HTB, NXCD = 8, WGM = 8;

__host__ __device__ __forceinline__ int lds_byte(int r, int c) { const int st = (r >> 4) * 2 + (c >> 5), rr = r & 15, cc = c & 31, ob = rr * 64 + cc * 2; return st * 1024 + (ob ^ (((ob >> 9) & 1) << 5)); }
__host__ __device__ __forceinline__ void stage_rc(int b, int& R, int& C) { const int st = b / 1024, sb = b % 1024, swz = sb ^ (((sb >> 9) & 1) << 5); R = (st >> 1) * 16 + swz / 64; C = (st & 1) * 32 + (swz % 64) / 2; }
__host__ __device__ __forceinline__ int perm32(int rho) { const int n = rho >> 4, i = rho & 15; return 8 * (i >> 2) + 4 * n + (i & 3); }

struct Unit { int pm, pn; };
struct Gemm { const bf16_t* A; const bf16_t* Bt; int M, N, K; };

struct StaticOrder {
    int nM, nN, nwg, G, c, lat_only, colmap;
    __host__ __device__ void init(int nM_, int nN_, int G_, int c_, int lat_only_, int colmap_ = 0) { nM = nM_; nN = nN_; nwg = nM * nN; G = G_; c = c_; lat_only = lat_only_; colmap = colmap_; }
    __host__ __device__ bool next(int i, Unit& u) const {
        const long L = (long)i * G + c; if (L >= nwg + (colmap == 1 ? 84 : 0)) return false;
        if (L >= nwg) { const int e = (int)L - nwg; u.pm = 24 + (e >> 1); u.pn = 22 + (e & 1); return true; }
        int wgid = (int)L; { const int q = nwg / NXCD, r = nwg % NXCD, xcd = wgid % NXCD, off = wgid / NXCD; wgid = (xcd < r ? xcd * (q + 1) : r * (q + 1) + (xcd - r) * q) + off; }
        const int nig = WGM * nN, gid = wgid / nig, fm = gid * WGM, gsz = (nM - fm) < WGM ? (nM - fm) : WGM;
        int pm = fm + ((wgid % nig) % gsz); u.pn = (wgid % nig) / gsz;
        if (lat_only) pm = pm + 1 + (pm >= 32 ? 1 : 0);
        if (colmap == 2) u.pn += 22;
        u.pm = pm; return true;
    }
    __device__ __forceinline__ void a_ready(const Unit&) const {}
    __device__ __forceinline__ void done(const Unit&) const {}
};
__device__ __forceinline__ unsigned cvt_pk_bf16(float lo, float hi) { unsigned r; asm volatile("v_cvt_pk_bf16_f32 %0, %1, %2" : "=v"(r) : "v"(lo), "v"(hi)); return r; }
typedef float f32x2 __attribute__((ext_vector_type(2)));
__device__ __forceinline__ float bf2f(unsigned short b) { return __uint_as_float(((unsigned)b) << 16); }
__device__ __forceinline__ float sigmoidf_(float x) { return 1.0f / (1.0f + __expf(-x)); }
__device__ __forceinline__ float siluf_(float x) { return x / (1.0f + __expf(-x)); }
struct EpiProj {
    static constexpr bool PERM = true, AFTER_DRAIN = false;
    bf16_t* proj; float* graw;
    __device__ __forceinline__ void operator()(const f32x4 (&acc)[2][2][4][2], const Unit& u, int wr, int wc, int fr, int fq) const {
        const int row0 = u.pm * BM + wr * 64 + fr; const int cst = u.pn * BM;
        if (cst >= 6144) {
            if (wc == 0 && fq < 2) {
#pragma unroll
                for (int ai = 0; ai < 2; ++ai)
#pragma unroll
                    for (int m = 0; m < 4; ++m) { float* gp = graw + (size_t)(row0 + ai * HALF + m * 16) * 16 + 8 * fq; *(f32x4*)gp = acc[ai][0][m][0]; *(f32x4*)(gp + 4) = acc[ai][0][m][1]; }
            }
            return;
        }
        int ss, ld;
        if (cst < 512) { ss = 0; ld = 512; } else if (cst < 1024) { ss = 512; ld = 512; } else if (cst < 2048) { ss = 1024; ld = 1024; } else if (cst < 2304) { ss = 2048; ld = 256; }
        else if (cst < 2560) { ss = 2304; ld = 256; } else if (cst < 3584) { ss = 2560; ld = 1024; } else { ss = 3584 + ((cst - 3584) >> 9) * 512; ld = 512; }
        bf16_t* base = proj + (size_t)NROWS * ss; const int col0 = cst - ss + wc * 32 + 8 * fq;
        const bool late = (ss == 512) || (ss == 2560) || (ss >= 5120);
#pragma unroll
        for (int ai = 0; ai < 2; ++ai)
#pragma unroll
            for (int m = 0; m < 4; ++m) { bf16_t* rowp = base + (size_t)(row0 + ai * HALF + m * 16) * ld + col0;
#pragma unroll
                for (int bj = 0; bj < 2; ++bj) { const f32x4 v0 = acc[ai][bj][m][0], v1 = acc[ai][bj][m][1];
                    u32x4 w; w.x = cvt_pk_bf16(v0[0], v0[1]); w.y = cvt_pk_bf16(v0[2], v0[3]); w.z = cvt_pk_bf16(v1[0], v1[1]); w.w = cvt_pk_bf16(v1[2], v1[3]);
                    if (late) __builtin_nontemporal_store(w, (u32x4*)(rowp + bj * HALF)); else *(u32x4*)(rowp + bj * HALF) = w; } }
    }
};
struct EpiGlu {
    static constexpr bool PERM = true, AFTER_DRAIN = false;
    const bf16_t* G; const bf16_t* Z; bf16_t* MIX;
    __device__ __forceinline__ void operator()(const f32x4 (&acc)[2][2][4][2], const Unit& u, int wr, int wc, int fr, int fq) const {
        const int row0 = u.pm * BM + wr * 64 + fr; const int col0 = u.pn * BM + wc * 32 + 8 * fq;
#pragma unroll
        for (int ai = 0; ai < 2; ++ai)
#pragma unroll
            for (int m = 0; m < 4; ++m) { const size_t row = (size_t)(row0 + ai * HALF + m * 16);
#pragma unroll
                for (int bj = 0; bj < 2; ++bj) { const int c = col0 + bj * HALF;
                    const u32x4 gw = *(const u32x4*)(G + row * 512 + c), zw = *(const u32x4*)(Z + row * 512 + c);
                    const f32x4 v0 = acc[ai][bj][m][0], v1 = acc[ai][bj][m][1];
                    float o[8];
#pragma unroll
                    for (int e = 0; e < 8; ++e) { const unsigned gq = gw[e >> 1], zq = zw[e >> 1];
                        const float g = (e & 1) ? __uint_as_float(gq & 0xffff0000u) : __uint_as_float(gq << 16);
                        const float z = (e & 1) ? __uint_as_float(zq & 0xffff0000u) : __uint_as_float(zq << 16);
                        const float a = e < 4 ? v0[e & 3] : v1[e & 3];
                        o[e] = g * sigmoidf_(a) * siluf_(z); }
                    u32x4 w; w.x = cvt_pk_bf16(o[0], o[1]); w.y = cvt_pk_bf16(o[2], o[3]); w.z = cvt_pk_bf16(o[4], o[5]); w.w = cvt_pk_bf16(o[6], o[7]);
                    *(u32x4*)(MIX + row * 2048 + c) = w; } }
    }
};
struct EpiOut {
    static constexpr bool PERM = true, AFTER_DRAIN = false;
    const float* lat_src; const float* ctx_src; float* lat_dst; float* ctx_dst; const float* ada;
    __device__ __forceinline__ void operator()(const f32x4 (&acc)[2][2][4][2], const Unit& u, int wr, int wc, int fr, int fq) const {
        const int b = u.pm / 33, j = u.pm % 33; const bool isc = (j == 0);
        const size_t roff = isc ? (size_t)(b * CTX) * DM : (size_t)(b * SEQ + (j - 1) * 256) * DM;
        const float* src = (isc ? ctx_src : lat_src) + roff; float* dst = (isc ? ctx_dst : lat_dst) + roff;
        const float* gate = ada + (isc ? 2 : b) * 6144 + 4096;
        const int col0 = u.pn * BM + wc * 32 + 8 * fq;
#pragma unroll
        for (int bj = 0; bj < 2; ++bj) { const int c = col0 + bj * HALF; const f32x4 g0 = *(const f32x4*)(gate + c), g1 = *(const f32x4*)(gate + c + 4);
#pragma unroll
            for (int ai = 0; ai < 2; ++ai) {
                f32x4 h0[4], h1[4];
#pragma unroll
                for (int m = 0; m < 4; ++m) { const size_t off = (size_t)(ai * HALF + wr * 64 + m * 16 + fr) * DM + c; h0[m] = *(const f32x4*)(src + off); h1[m] = *(const f32x4*)(src + off + 4); }
#pragma unroll
                for (int m = 0; m < 4; ++m) { const size_t off = (size_t)(ai * HALF + wr * 64 + m * 16 + fr) * DM + c;
                    *(f32x4*)(dst + off) = h0[m] + g0 * acc[ai][bj][m][0]; *(f32x4*)(dst + off + 4) = h1[m] + g1 * acc[ai][bj][m][1]; }
            } }
    }
};

struct EpiDelta {
    static constexpr bool PERM = true, AFTER_DRAIN = false;
    bf16_t* delta; const float* ada; int ld;
    __device__ __forceinline__ void operator()(const f32x4 (&acc)[2][2][4][2], const Unit& u, int wr, int wc, int fr, int fq) const {
        const int b = u.pm / 33, j = u.pm % 33;
        bf16_t* dst = delta + (size_t)(b * SEQ + (j - 1) * 256) * ld; const float* gate = ada + b * 6144 + 4096;
        const int col0 = u.pn * BM + wc * 32 + 8 * fq;
#pragma unroll
        for (int bj = 0; bj < 2; ++bj) { const int c = col0 + bj * HALF; const f32x4 g0 = *(const f32x4*)(gate + c), g1 = *(const f32x4*)(gate + c + 4);
#pragma unroll
            for (int ai = 0; ai < 2; ++ai)
#pragma unroll
                for (int m = 0; m < 4; ++m) { const f32x4 v0 = g0 * acc[ai][bj][m][0], v1 = g1 * acc[ai][bj][m][1];
                    u32x4 w; w.x = cvt_pk_bf16(v0[0], v0[1]); w.y = cvt_pk_bf16(v0[2], v0[3]); w.z = cvt_pk_bf16(v1[0], v1[1]); w.w = cvt_pk_bf16(v1[2], v1[3]);
                    *(u32x4*)(dst + (size_t)(ai * HALF + wr * 64 + m * 16 + fr) * ld + c) = w; } }
    }
};
template <class Epi, class Sched, bool ALIGN_EPI = false, bool SP2 = false>
__device__ __forceinline__ void gemm_phase(PG8_LAS unsigned char* lds, const Gemm g, const Sched& S, const Epi& E) {
    int tid_ = threadIdx.x; asm volatile("" : "+v"(tid_));
    const int tid = tid_, wid = __builtin_amdgcn_readfirstlane(tid >> 6), lane = tid & 63, wr = wid >> 2, wc = wid & 3, fr = lane & 15, fq = lane >> 4;
    const int K = g.K, nt = K / BK;
    unsigned voffA[2], voffB[2];
#pragma unroll
    for (int i = 0; i < 2; ++i) { int R, C; stage_rc(tid * 16 + i * 8192, R, C); const int Rb = Epi::PERM ? ((R & ~31) + perm32(R & 31)) : R;
        voffA[i] = (unsigned)(R * K + C) * 2u; voffB[i] = (unsigned)(Rb * K + C) * 2u; }
    const size_t kstep = (size_t)(BK * 2);
    const size_t hstep = (size_t)HALF * K * 2;
    const size_t tstep = 2 * hstep;
    const unsigned ldsw = (unsigned)wid * 1024u;
    const int aoff = lds_byte(wr * 64 + fr, fq * 8), boff = lds_byte(wc * 32 + fr, fq * 8);
#define PG8_SA(b, h) (((b) * 2 + (h)) * HTB)
#define PG8_SB(b, h) ((4 + (b) * 2 + (h)) * HTB)
#define PG8_STAGE(bufoff, gbase, voff) do { _Pragma("unroll") for (int _i = 0; _i < 2; ++_i) \
        __builtin_amdgcn_global_load_lds((const unsigned*)((const char*)(gbase) + (voff)[_i]), (PG8_LAS unsigned*)(lds + (bufoff) + ldsw + _i * 8192), 16, 0, 0); } while (0)
#define PG8_LDA(dst, b, h) do { _Pragma("unroll") for (int m = 0; m < 4; ++m) _Pragma("unroll") for (int k = 0; k < 2; ++k) dst[m][k] = *(const PG8_LAS bf16x8*)(lds + PG8_SA(b, h) + aoff + m * 2048 + k * 1024); } while (0)
#define PG8_LDB(dst, b, h) do { _Pragma("unroll") for (int n = 0; n < 2; ++n) _Pragma("unroll") for (int k = 0; k < 2; ++k) dst[n][k] = *(const PG8_LAS bf16x8*)(lds + PG8_SB(b, h) + boff + n * 2048 + k * 1024); } while (0)
#define PG8_MMA(ai, bj, At, Bt) do { __builtin_amdgcn_s_setprio(1); _Pragma("unroll") for (int m = 0; m < 4; ++m) _Pragma("unroll") for (int n = 0; n < 2; ++n) _Pragma("unroll") for (int k = 0; k < 2; ++k) \
        acc[ai][bj][m][n] = __builtin_amdgcn_mfma_f32_16x16x32_bf16(Bt[n][k], At[m][k], acc[ai][bj][m][n], 0, 0, 0); __builtin_amdgcn_s_setprio(0); } while (0)
#define PG8_WAIT_V(n) asm volatile("s_waitcnt vmcnt(" #n ")" ::: "memory")
#define PG8_WAIT_L(n) asm volatile("s_waitcnt lgkmcnt(" #n ")" ::: "memory")
#define PG8_BAR __builtin_amdgcn_s_barrier()
#define PG8_SCHED __builtin_amdgcn_sched_barrier(0)
    Unit cur, nxt; int ui = 0;
    if (!S.next(0, cur)) return;
    f32x4 acc[2][2][4][2];
#pragma unroll
    for (int a = 0; a < 2; ++a)
#pragma unroll
        for (int b = 0; b < 2; ++b)
#pragma unroll
            for (int m = 0; m < 4; ++m)
#pragma unroll
                for (int n = 0; n < 2; ++n) acc[a][b][m][n] = (f32x4){0.f, 0.f, 0.f, 0.f};
    bf16x8 At[4][2], B0[2][2], B1[2][2];
    const char* cA = (const char*)g.A + (size_t)cur.pm * tstep; const char* cB = (const char*)g.Bt + (size_t)cur.pn * tstep;
    S.a_ready(cur);
    if constexpr (SP2) {
        PG8_STAGE(PG8_SB(0, 0), cB, voffB); PG8_STAGE(PG8_SB(0, 1), cB + hstep, voffB); PG8_STAGE(PG8_SA(0, 0), cA, voffA); PG8_STAGE(PG8_SA(0, 1), cA + hstep, voffA);
        if (wr == 1) PG8_BAR;
        PG8_WAIT_V(2); PG8_BAR;
        PG8_STAGE(PG8_SB(1, 0), cB + kstep, voffB); PG8_STAGE(PG8_SA(1, 0), cA + kstep, voffA); PG8_STAGE(PG8_SB(1, 1), cB + hstep + kstep, voffB);
        PG8_WAIT_V(6); PG8_BAR;
    } else {
        PG8_STAGE(PG8_SB(0, 0), cB, voffB); PG8_STAGE(PG8_SA(0, 0), cA, voffA); PG8_STAGE(PG8_SB(0, 1), cB + hstep, voffB); PG8_STAGE(PG8_SA(0, 1), cA + hstep, voffA);
        if (wr == 1) PG8_BAR;
        PG8_WAIT_V(4); PG8_BAR;
        PG8_STAGE(PG8_SB(1, 0), cB + kstep, voffB); PG8_STAGE(PG8_SA(1, 0), cA + kstep, voffA); PG8_STAGE(PG8_SB(1, 1), cB + hstep + kstep, voffB);
        PG8_WAIT_V(6); PG8_BAR;
    }
    for (;;) {
        const bool has_next = S.next(ui + 1, nxt);
        const char* nA = has_next ? (const char*)g.A + (size_t)nxt.pm * tstep : cA; const char* nB = has_next ? (const char*)g.Bt + (size_t)nxt.pn * tstep : cB;
        for (int t = 0; t < nt; t += 2) {
            const bool last = (t == nt - 2);
            const char* a1 = cA + (size_t)(t + 1) * kstep;
            const char* a2 = last ? nA : cA + (size_t)(t + 2) * kstep; const char* b2 = last ? nB : cB + (size_t)(t + 2) * kstep;
            const char* a3 = a2 + kstep; const char* b3 = b2 + kstep;
            if (last && has_next) S.a_ready(nxt);
            if constexpr (SP2) {
            PG8_LDB(B0, 0, 0); PG8_LDB(B1, 0, 1); PG8_SCHED; PG8_LDA(At, 0, 0); PG8_STAGE(PG8_SA(1, 1), a1 + hstep, voffA);
            PG8_WAIT_V(8); PG8_WAIT_L(0); PG8_BAR; PG8_MMA(0, 0, At, B0); PG8_MMA(0, 1, At, B1); PG8_BAR; PG8_SCHED;
            PG8_LDA(At, 0, 1); PG8_STAGE(PG8_SB(0, 0), b2, voffB); PG8_STAGE(PG8_SB(0, 1), b2 + hstep, voffB); PG8_STAGE(PG8_SA(0, 0), a2, voffA);
            PG8_WAIT_V(8); PG8_WAIT_L(0); PG8_BAR; PG8_MMA(1, 0, At, B0); PG8_MMA(1, 1, At, B1); PG8_BAR; PG8_SCHED;
            PG8_LDB(B0, 1, 0); PG8_LDB(B1, 1, 1); PG8_SCHED; PG8_LDA(At, 1, 0); PG8_STAGE(PG8_SA(0, 1), a2 + hstep, voffA);
            PG8_WAIT_V(8); PG8_WAIT_L(0); PG8_BAR; PG8_MMA(0, 0, At, B0); PG8_MMA(0, 1, At, B1); PG8_BAR; PG8_SCHED;
            PG8_LDA(At, 1, 1); PG8_STAGE(PG8_SB(1, 0), b3, voffB); PG8_STAGE(PG8_SB(1, 1), b3 + hstep, voffB); PG8_STAGE(PG8_SA(1, 0), a3, voffA);
            PG8_WAIT_V(8); PG8_WAIT_L(0); PG8_BAR; PG8_MMA(1, 0, At, B0); PG8_MMA(1, 1, At, B1); PG8_BAR; PG8_SCHED;
            } else {
            PG8_LDB(B0, 0, 0); PG8_SCHED; PG8_LDA(At, 0, 0); PG8_STAGE(PG8_SA(1, 1), a1 + hstep, voffA);
            PG8_WAIT_L(8); PG8_BAR; PG8_WAIT_L(0); PG8_MMA(0, 0, At, B0); PG8_BAR; PG8_SCHED;
            PG8_LDB(B1, 0, 1); PG8_STAGE(PG8_SB(0, 0), b2, voffB);
            PG8_BAR; PG8_WAIT_L(0); PG8_MMA(0, 1, At, B1); PG8_BAR;
            PG8_LDA(At, 0, 1); PG8_STAGE(PG8_SA(0, 0), a2, voffA);
            PG8_BAR; PG8_WAIT_L(0); PG8_MMA(1, 0, At, B0); PG8_BAR; PG8_SCHED;
            PG8_STAGE(PG8_SB(0, 1), b2 + hstep, voffB);
            PG8_WAIT_V(6); PG8_BAR; PG8_MMA(1, 1, At, B1); PG8_BAR;
            PG8_LDB(B0, 1, 0); PG8_SCHED; PG8_LDA(At, 1, 0); PG8_STAGE(PG8_SA(0, 1), a2 + hstep, voffA);
            PG8_WAIT_L(8); PG8_BAR; PG8_WAIT_L(0); PG8_MMA(0, 0, At, B0); PG8_BAR; PG8_SCHED;
            PG8_LDB(B1, 1, 1); PG8_STAGE(PG8_SB(1, 0), b3, voffB);
            PG8_BAR; PG8_WAIT_L(0); PG8_MMA(0, 1, At, B1); PG8_BAR;
            PG8_LDA(At, 1, 1); PG8_STAGE(PG8_SA(1, 0), a3, voffA);
            PG8_BAR; PG8_WAIT_L(0); PG8_MMA(1, 0, At, B0); PG8_BAR; PG8_SCHED;
            PG8_STAGE(PG8_SB(1, 1), b3 + hstep, voffB);
            PG8_WAIT_V(6); PG8_BAR; PG8_MMA(1, 1, At, B1); PG8_BAR;
            }
        }
        if constexpr (ALIGN_EPI) { if (wr == 0) PG8_BAR; }
        if constexpr (!Epi::AFTER_DRAIN) { E(acc, cur, wr, wc, fr, fq); S.done(cur); }
        if (!has_next) break;
#pragma unroll
        for (int a = 0; a < 2; ++a)
#pragma unroll
            for (int b = 0; b < 2; ++b)
#pragma unroll
                for (int m = 0; m < 4; ++m)
#pragma unroll
                    for (int n = 0; n < 2; ++n) acc[a][b][m][n] = (f32x4){0.f, 0.f, 0.f, 0.f};
        cur = nxt; cA = nA; cB = nB; ++ui;
        if constexpr (ALIGN_EPI) { if (wr == 1) PG8_BAR; }
    }
    PG8_WAIT_V(0);
    if constexpr (!ALIGN_EPI) { if (wr == 0) PG8_BAR; }
    PG8_BAR;
    if constexpr (Epi::AFTER_DRAIN) { E.fused(acc, cur, wr, wc, fr, fq, lds, wid, lane); S.done(cur); }
#undef PG8_SA
#undef PG8_SB
#undef PG8_STAGE
#undef PG8_LDA
#undef PG8_LDB
#undef PG8_MMA
#undef PG8_WAIT_V
#undef PG8_WAIT_L
#undef PG8_BAR
#undef PG8_SCHED
}
}
namespace attn {
using bf16 = unsigned short;
constexpr int D = 128, NW = 8, QBLK = 32, KVBLK = 64;
constexpr float SCALE = 0.088388347648318440f;
constexpr float THR = 8.f;
constexpr int SDEPTH = 1;
constexpr int LDQ = 1024, LDK = 256, LDZ = 1024, LDM = 2048;
constexpr int NSLOT = 3;
constexpr size_t SHM_V = KVBLK * D * 2, SHM_K = KVBLK * D * 2, SHM_ATTN = NSLOT * SHM_V + NSLOT * SHM_K + NW * 64 * 4;
using bf16x8 = __attribute__((ext_vector_type(8))) short;
using s16x4  = __attribute__((ext_vector_type(4))) short;
using f32x16 = __attribute__((ext_vector_type(16))) float;
using f32x8  = __attribute__((ext_vector_type(8))) float;
using u32x4  = __attribute__((ext_vector_type(4))) unsigned;
#define KSWZ(row, colB) ((row) * 256 + ((colB) ^ (((row) & 7) << 4)))
#define SBAR() __builtin_amdgcn_sched_barrier(0)
__device__ __forceinline__ int crow(int r, int hi) { return (r & 3) + 8 * (r >> 2) + 4 * hi; }
__device__ __forceinline__ unsigned cvtpk(float lo, float hi) {
  unsigned r; asm volatile("v_cvt_pk_bf16_f32 %0, %1, %2" : "=v"(r) : "v"(lo), "v"(hi)); return r;
}

__device__ __forceinline__ void partialSM(f32x16& p0) {
  for (int r = 0; r < 16; ++r) p0[r] = __builtin_amdgcn_exp2f(p0[r]);
}
__device__ __forceinline__ void finishSM(f32x16& p0, f32x16& p1, float& l_reg, bf16x8& pa0, bf16x8& pa1, bf16x8& pa2, bf16x8& pa3) {
  for (int r = 0; r < 16; ++r) p1[r] = __builtin_amdgcn_exp2f(p1[r]);
  typedef float f32x2a __attribute__((ext_vector_type(2)));
  f32x2a a2 = {0.f, 0.f}, b2 = {0.f, 0.f};
#pragma unroll
  for (int r = 0; r < 16; r += 2) { a2 = a2 + (f32x2a){p0[r], p0[r + 1]}; b2 = b2 + (f32x2a){p1[r], p1[r + 1]}; }
  a2 = a2 + b2; float ps = a2.x + a2.y;
  { auto rr = __builtin_amdgcn_permlane32_swap(__float_as_uint(ps), __float_as_uint(ps), false, false);
    ps = __uint_as_float(rr[0]) + __uint_as_float(rr[1]); }
  l_reg += ps;
#define PK4(P, BASE, OUT) do { unsigned a0 = cvtpk(P[BASE + 0], P[BASE + 1]), a1 = cvtpk(P[BASE + 2], P[BASE + 3]);   \
    unsigned b0 = cvtpk(P[BASE + 4], P[BASE + 5]), b1 = cvtpk(P[BASE + 6], P[BASE + 7]);                              \
    auto r0 = __builtin_amdgcn_permlane32_swap(a0, b0, false, false); auto r1 = __builtin_amdgcn_permlane32_swap(a1, b1, false, false); \
    u32x4 w = {r0[0], r1[0], r0[1], r1[1]}; OUT = *reinterpret_cast<bf16x8*>(&w); } while (0)
  PK4(p0, 0, pa0); PK4(p0, 8, pa1); PK4(p1, 0, pa2); PK4(p1, 8, pa3);
#undef PK4
}
__device__ __forceinline__ void qkt(f32x16& p0, f32x16& p1, const bf16* Ks, const bf16x8* qr, const f32x16& negm, int r32, int hi) {
  for (int d0 = 0; d0 < 8; ++d0) { int cb = (d0 * 16 + hi * 8) * 2;
    bf16x8 b0 = *reinterpret_cast<const bf16x8*>((const char*)Ks + KSWZ(r32, cb));
    bf16x8 b1 = *reinterpret_cast<const bf16x8*>((const char*)Ks + KSWZ(32 + r32, cb));
    if (d0 == 0) { p0 = __builtin_amdgcn_mfma_f32_32x32x16_bf16(b0, qr[0], negm, 0, 0, 0); p1 = __builtin_amdgcn_mfma_f32_32x32x16_bf16(b1, qr[0], negm, 0, 0, 0); }
    else { p0 = __builtin_amdgcn_mfma_f32_32x32x16_bf16(b0, qr[d0], p0, 0, 0, 0); p1 = __builtin_amdgcn_mfma_f32_32x32x16_bf16(b1, qr[d0], p1, 0, 0, 0); } }
}
__device__ __forceinline__ int v_st(int k, int c) { const int kk = (k & ~0xC) | ((k & 4) << 1) | ((k & 8) >> 1); return ((kk >> 3) * 4 + (c >> 5)) * 512 + ((kk & 7) * 32 + (c & 31)) * 2; }
__device__ __forceinline__ int v_rd_base(int lane) { return ((lane & 3) << 3) | (((lane >> 2) & 3) << 6) | (((lane >> 4) & 1) << 5) | (((lane >> 5) & 1) << 8); }
constexpr int v_rd_off(int d0, int ks, int half) { return d0 * 512 + ks * 4096 + half * 2048; }
template <int OFF> __device__ __forceinline__ s16x4 tr_read(int vb) {
  s16x4 r; asm volatile("ds_read_b64_tr_b16 %0, %1 offset:%2" : "=&v"(r) : "v"(vb), "i"(OFF) : "memory"); return r;
}
template <int D0> __device__ __forceinline__ void pv_one(f32x16& od, int vb, bf16x8 pa0, bf16x8 pa1, bf16x8 pa2, bf16x8 pa3) {
  const s16x4 l0 = tr_read<v_rd_off(D0, 0, 0)>(vb), h0 = tr_read<v_rd_off(D0, 0, 1)>(vb), l1 = tr_read<v_rd_off(D0, 1, 0)>(vb), h1 = tr_read<v_rd_off(D0, 1, 1)>(vb);
  const s16x4 l2 = tr_read<v_rd_off(D0, 2, 0)>(vb), h2 = tr_read<v_rd_off(D0, 2, 1)>(vb), l3 = tr_read<v_rd_off(D0, 3, 0)>(vb), h3 = tr_read<v_rd_off(D0, 3, 1)>(vb);
  asm volatile("s_waitcnt lgkmcnt(0)" ::: "memory"); SBAR();
#define PK(L, H) (bf16x8){L[0], L[1], L[2], L[3], H[0], H[1], H[2], H[3]}
  od = __builtin_amdgcn_mfma_f32_32x32x16_bf16(pa0, PK(l0, h0), od, 0, 0, 0);
  od = __builtin_amdgcn_mfma_f32_32x32x16_bf16(pa1, PK(l1, h1), od, 0, 0, 0);
  od = __builtin_amdgcn_mfma_f32_32x32x16_bf16(pa2, PK(l2, h2), od, 0, 0, 0);
  od = __builtin_amdgcn_mfma_f32_32x32x16_bf16(pa3, PK(l3, h3), od, 0, 0, 0);
#undef PK
}
__device__ __forceinline__ void pv_d0(f32x16* o, int vb, bf16x8 pa0, bf16x8 pa1, bf16x8 pa2, bf16x8 pa3) {
  pv_one<0>(o[0], vb, pa0, pa1, pa2, pa3); pv_one<1>(o[1], vb, pa0, pa1, pa2, pa3); pv_one<2>(o[2], vb, pa0, pa1, pa2, pa3); pv_one<3>(o[3], vb, pa0, pa1, pa2, pa3);
}
__device__ __forceinline__ bf16x8 ld8(const bf16* p) { return *reinterpret_cast<const bf16x8*>(p); }
template <bool LATE>
__device__ __forceinline__ void attn_dense_half(const bf16* __restrict__ Qb, const bf16* __restrict__ Kh, const bf16* __restrict__ Vh,
                                                const bf16* __restrict__ Zb, bf16* __restrict__ Mb, int seq, float negmv, char* lds, const float* qnw, const float* rope0) {
  int tid_ = threadIdx.x; asm volatile("" : "+v"(tid_));
  const int tid = tid_, wid = tid >> 6, lane = tid & 63, r32 = lane & 31, hi = lane >> 5;
  bf16* V_lds = (bf16*)lds; bf16* K_lds = (bf16*)(lds + NSLOT * SHM_V);
  float* ws = (float*)(lds + NSLOT * SHM_V + NSLOT * SHM_K) + wid * 64; float* li_l = ws;
  float l_reg = 0; f32x16 o[4] = {}; bf16x8 qr[8];
  f32x16 negm; for (int r = 0; r < 16; ++r) negm[r] = negmv; asm volatile("" : "+v"(negm));
  const bf16* Qw = Qb + (long)(wid * QBLK + r32) * LDQ + hi * 8;
#pragma unroll
  for (int d0 = 0; d0 < 8; ++d0) qr[d0] = ld8(Qw + d0 * 16);
  {
    const float* rp = rope0 ? rope0 + ((size_t)(wid * QBLK + r32) * 64 + hi * 8) * 2 : qnw;
    f32x8 c0[4], c1[4];
#pragma unroll
    for (int s4 = 0; s4 < 4; ++s4) { c0[s4] = *(const f32x8*)(rp + (rope0 ? 32 * s4 : 0)); c1[s4] = *(const f32x8*)(rp + (rope0 ? 32 * s4 + 8 : 0)); }
    float ss = 0.f;
#pragma unroll
    for (int d0 = 0; d0 < 8; ++d0)
#pragma unroll
      for (int j = 0; j < 8; ++j) { const float v = __uint_as_float((unsigned)(unsigned short)qr[d0][j] << 16); ss += v * v; }
    ss += __shfl_xor(ss, 32);
    const float rstd = rsqrtf(ss * (1.0f / 128.0f) + 1e-6f) * (SCALE * 1.4426950408889634f);
    const bool norope = (rope0 == nullptr);
#pragma unroll
    for (int s4 = 0; s4 < 4; ++s4) {
      const f32x8 w1s = *(const f32x8*)(qnw + 16 * s4 + 8 * hi), w2s = *(const f32x8*)(qnw + 64 + 16 * s4 + 8 * hi);
      bf16x8 o1, o2;
#pragma unroll
      for (int j = 0; j < 8; j += 2) {
        float r1[2], r2[2];
#pragma unroll
        for (int e = 0; e < 2; ++e) { const int jj = j + e;
          const float y1 = __uint_as_float((unsigned)(unsigned short)qr[s4][jj] << 16) * rstd * w1s[jj], y2 = __uint_as_float((unsigned)(unsigned short)qr[s4 + 4][jj] << 16) * rstd * w2s[jj];
          const float c = norope ? 1.f : (jj < 4 ? c0[s4][2 * jj] : c1[s4][2 * (jj - 4)]), sn = norope ? 0.f : (jj < 4 ? c0[s4][2 * jj + 1] : c1[s4][2 * (jj - 4) + 1]);
          r1[e] = y1 * c - y2 * sn; r2[e] = y1 * sn + y2 * c; }
        const unsigned p1 = cvtpk(r1[0], r1[1]), p2 = cvtpk(r2[0], r2[1]);
        o1[j] = (short)(p1 & 0xffffu); o1[j + 1] = (short)(p1 >> 16); o2[j] = (short)(p2 & 0xffffu); o2[j + 1] = (short)(p2 >> 16); }
      qr[s4] = o1; qr[s4 + 4] = o2;
    }
  }
  const int sr = tid >> 4, sc = (tid & 15) * 8, vst0 = v_st(sr, sc), vst1 = v_st(32 + sr, sc);
  const int vb0 = (int)(uintptr_t)V_lds + v_rd_base(lane);
  struct { bf16x8 vs0, vs1, ks0, ks1; } sr_[SDEPTH];
#define SLOAD(i, k0) do { sr_[i].vs0 = ld8(&Vh[(long)((k0) + sr) * LDK + sc]); sr_[i].vs1 = ld8(&Vh[(long)((k0) + 32 + sr) * LDK + sc]); \
    sr_[i].ks0 = ld8(&Kh[(long)((k0) + sr) * LDK + sc]); sr_[i].ks1 = ld8(&Kh[(long)((k0) + 32 + sr) * LDK + sc]); } while (0)
#define SWRITE(soff, i) do { *(bf16x8*)((char*)V_lds + (soff) + vst0) = sr_[i].vs0;          \
    *(bf16x8*)((char*)V_lds + (soff) + vst1) = sr_[i].vs1; int kc = sc * 2;               \
    *(bf16x8*)((char*)K_lds + (soff) + KSWZ(sr, kc)) = sr_[i].ks0;                       \
    *(bf16x8*)((char*)K_lds + (soff) + KSWZ(32 + sr, kc)) = sr_[i].ks1; } while (0)
#define SWAIT() do { if constexpr (SDEPTH == 2) asm volatile("s_waitcnt vmcnt(4)" ::: "memory"); else asm volatile("s_waitcnt vmcnt(0)" ::: "memory"); } while (0)
#define ROT() do { const int t_ = s_prev; s_prev = s_cur; s_cur = s_next; s_next = t_; } while (0)
  f32x16 pA0, pA1, pB0, pB1; bf16x8 pa0, pa1, pa2, pa3; const int NT = seq / KVBLK;
  constexpr int SE = 0, SO = SDEPTH - 1;
  int s_prev = 0, s_cur = (int)SHM_V, s_next = 2 * (int)SHM_V;
  SLOAD(SE, 0); asm volatile("s_waitcnt vmcnt(0)" ::: "memory"); SWRITE(0, SE); __syncthreads();
  qkt(pA0, pA1, K_lds, qr, negm, r32, hi); if constexpr (!LATE) partialSM(pA0);
  SLOAD(SO, KVBLK); if constexpr (SDEPTH == 2) { if (2 < NT) SLOAD(SE, 2 * KVBLK); }
  SWAIT(); SWRITE(s_cur, SO); __syncthreads();
  for (int j = 1; j + 1 < NT; j += 2) {
    if constexpr (LATE) { partialSM(pA0); }
    SBAR(); qkt(pB0, pB1, (bf16*)((char*)K_lds + s_cur), qr, negm, r32, hi);
    finishSM(pA0, pA1, l_reg, pa0, pa1, pa2, pa3); SBAR();
    SLOAD(SO, (j + SDEPTH) * KVBLK); SBAR();
    pv_d0(o, vb0 + s_prev, pa0, pa1, pa2, pa3); if constexpr (!LATE) partialSM(pB0);
    SWAIT(); SWRITE(s_next, SE);
    __syncthreads(); ROT();
    if constexpr (LATE) { partialSM(pB0); }
    SBAR(); qkt(pA0, pA1, (bf16*)((char*)K_lds + s_cur), qr, negm, r32, hi);
    finishSM(pB0, pB1, l_reg, pa0, pa1, pa2, pa3); SBAR();
    if (SDEPTH == 1 || j + 3 < NT) SLOAD(SE, (j + 1 + SDEPTH) * KVBLK); SBAR();
    pv_d0(o, vb0 + s_prev, pa0, pa1, pa2, pa3); if constexpr (!LATE) partialSM(pA0);
    SWAIT(); SWRITE(s_next, SO);
    __syncthreads(); ROT();
  }
  if constexpr (LATE) { partialSM(pA0); }
  SBAR(); qkt(pB0, pB1, (bf16*)((char*)K_lds + s_cur), qr, negm, r32, hi);
  finishSM(pA0, pA1, l_reg, pa0, pa1, pa2, pa3); SBAR();
  pv_d0(o, vb0 + s_prev, pa0, pa1, pa2, pa3); partialSM(pB0);
  finishSM(pB0, pB1, l_reg, pa0, pa1, pa2, pa3); SBAR();
  pv_d0(o, vb0 + s_cur, pa0, pa1, pa2, pa3);
  if (hi == 0) li_l[r32] = l_reg; asm volatile("s_waitcnt lgkmcnt(0)" ::: "memory");
  float rli[16];
#pragma unroll
  for (int r = 0; r < 16; ++r) rli[r] = __builtin_amdgcn_rcpf(li_l[crow(r, hi)]);
  __syncthreads();
  { bf16* stg = (bf16*)(lds + wid * 8704);
#pragma unroll
    for (int r = 0; r < 16; ++r) { const int orow = crow(r, hi);
#pragma unroll
      for (int d0 = 0; d0 < 4; ++d0) { const float v = o[d0][r] * rli[r]; const unsigned u = __float_as_uint(v); stg[orow * 136 + d0 * 32 + r32] = (bf16)((u + 0x7fffu + ((u >> 16) & 1u)) >> 16); } }
    asm volatile("s_waitcnt lgkmcnt(0)" ::: "memory");
    const bf16* Zw = Zb + (long)(wid * QBLK) * LDZ; bf16* Mw = Mb + (long)(wid * QBLK) * LDM;
    u32x4 zv[8];
#pragma unroll
    for (int i = 0; i < 8; ++i) { const int c = lane + 64 * i, row = c >> 4, c8 = (c & 15) * 8; zv[i] = *(const u32x4*)(Zw + (long)row * LDZ + c8); }
#pragma unroll
    for (int i = 0; i < 8; ++i) { const int c = lane + 64 * i, row = c >> 4, c8 = (c & 15) * 8; const u32x4 ov = *(const u32x4*)(stg + row * 136 + c8); u32x4 w;
#pragma unroll
      for (int e = 0; e < 4; ++e) { const float z0 = __uint_as_float(zv[i][e] << 16), z1 = __uint_as_float(zv[i][e] & 0xffff0000u);
        const float a0 = __uint_as_float(ov[e] << 16) * z0 * __builtin_amdgcn_rcpf(1.0f + __expf(-z0)), a1 = __uint_as_float(ov[e] & 0xffff0000u) * z1 * __builtin_amdgcn_rcpf(1.0f + __expf(-z1));
        w[e] = cvtpk(a0, a1); }
      *(u32x4*)(Mw + (long)row * LDM + c8) = w; }
  }
  __syncthreads();
#undef SLOAD
#undef SWRITE
#undef SWAIT
#undef ROT
}
__device__ __forceinline__ void attn_dense_body(const bf16* __restrict__ Qb, const bf16* __restrict__ Kh, const bf16* __restrict__ Vh,
                                                const bf16* __restrict__ Zb, bf16* __restrict__ Mb, int seq, float negmv, char* lds, const float* qnw, const float* rope0) {
  if (__builtin_amdgcn_readfirstlane((int)threadIdx.x >> 6) < 4) attn_dense_half<false>(Qb, Kh, Vh, Zb, Mb, seq, negmv, lds, qnw, rope0);
  else attn_dense_half<true>(Qb, Kh, Vh, Zb, Mb, seq, negmv, lds, qnw, rope0);
}
#undef KSWZ
#undef SBAR
}
typedef unsigned short bf16_t;
typedef short bf16x8 __attribute__((ext_vector_type(8)));
typedef float f32x4 __attribute__((ext_vector_type(4)));
typedef float f32x8 __attribute__((ext_vector_type(8)));
typedef unsigned u32x4 __attribute__((ext_vector_type(4)));
typedef unsigned u32x2 __attribute__((ext_vector_type(2)));
#define LAS __attribute__((address_space(3)))
constexpr size_t al256(size_t x) { return (x + 255) / 256 * 256; }
constexpr size_t W_MISC = 32768;
constexpr size_t W_WIN = 1u << 20;
constexpr size_t SZ_WIN = (size_t)NPROJ * DM * 2, SZ_WOUT = (size_t)DM * DM * 2, SZ_WGLU = (size_t)512 * 512 * 2;
constexpr size_t W_WOUT = W_WIN + 2 * SZ_WIN;
constexpr size_t W_WGLU = W_WOUT + 2 * SZ_WOUT;
constexpr size_t W_XN = W_WGLU + 2 * SZ_WGLU;
constexpr size_t W_PROJ = W_XN + (size_t)NROWS * DM * 2;
constexpr size_t W_GRAW = W_PROJ + (size_t)NROWS * 6144 * 2;
constexpr size_t W_GD = W_GRAW + (size_t)NROWS * 16 * 4;
constexpr size_t W_CQ = W_GD + (size_t)NROWS * 16 * 4;
constexpr size_t W_CK = W_CQ + (size_t)NROWS * 512 * 2;
constexpr size_t W_STC = W_CK + (size_t)NROWS * 512 * 2;
constexpr size_t W_STN = W_STC + (size_t)16 * 66 * 16384 * 4;
constexpr size_t W_STS = W_STN + (size_t)16 * 66 * 128 * 4;
constexpr size_t W_S5F = W_STS + al256(16 * 66 * 4 * 4);
constexpr size_t W_HCTX = W_S5F + (size_t)2 * 32 * 2 * 66 * 128 * 4;
constexpr size_t W_ROPE = W_HCTX + (size_t)512 * DM * 4;
constexpr size_t W_ADAP = W_ROPE + (size_t)SEQ * 64 * 2 * 4;
constexpr size_t W_ADA = W_ADAP + (size_t)2 * 128 * 3 * 6144 * 4;
constexpr size_t W_LAM = W_ADA + (size_t)2 * 3 * 6144 * 4;
constexpr size_t W_LAMT = W_LAM + (size_t)2 * 2 * 32 * 64 * 2 * 4;
constexpr size_t W_BBT = W_LAMT + (size_t)2 * 2 * 32 * 64 * 2 * 4;
constexpr size_t W_CMT = W_BBT + (size_t)2 * 2 * 32 * 128 * 16 * 4;
constexpr size_t W_CB = W_CMT + (size_t)2 * 2 * 32 * 128 * 16 * 4;
constexpr size_t W_SLOTS = W_CB + (size_t)16 * 66 * 16384 * 2;
constexpr size_t W_END = W_SLOTS + (size_t)66 * 8 * 256 * 4;
static_assert(W_END <= (size_t)512 * 1024 * 1024, "workspace map exceeds 512 MiB");
constexpr int SEC_S5U = 0, SEC_S5Z = 512, SEC_ATQ = 1024, SEC_ATK = 2048, SEC_ATV = 2304, SEC_ATZ = 2560, SEC_MLQ = 3584, SEC_MLK = 4096, SEC_MLV = 4608, SEC_MLO = 5120, SEC_MLZ = 5632;
constexpr int LDS_BYTES = 147456;
constexpr int NTHR = 512;

struct Params { const float* in[25]; float* out; unsigned char* ws; };
enum { I_X = 0, I_C, I_CTX, I_CCTX, I_NORMW, I_ADAW, I_ADAB, I_WIN, I_GATEB, I_ARE, I_AIM, I_LOGDT, I_BRE, I_BIM, I_CRE, I_CIM, I_SSMD, I_WGLU, I_QNORM, I_KNORM, I_CONVW, I_CONVB, I_MNORM, I_WOUT, I_FNORM };

__device__ __forceinline__ float bf2f(unsigned short b) { return __uint_as_float(((unsigned)b) << 16); }
__device__ __forceinline__ unsigned short f2bf(float f) { unsigned u = __float_as_uint(f); return (unsigned short)((u + 0x7fffu + ((u >> 16) & 1u)) >> 16); }
typedef float f32x2_t __attribute__((ext_vector_type(2))); typedef __bf16 bf16x2_t __attribute__((ext_vector_type(2)));
__device__ __forceinline__ unsigned pk2(float lo, float hi) { f32x2_t v = {lo, hi}; bf16x2_t b = __builtin_convertvector(v, bf16x2_t); return __builtin_bit_cast(unsigned, b); }
__device__ __forceinline__ float lo16(unsigned w) { return __uint_as_float(w << 16); }
__device__ __forceinline__ float hi16(unsigned w) { return __uint_as_float(w & 0xffff0000u); }
__device__ __forceinline__ float sigm(float x) { return __builtin_amdgcn_rcpf(1.0f + __expf(-x)); }
__device__ __forceinline__ float silu(float x) { return x * __builtin_amdgcn_rcpf(1.0f + __expf(-x)); }
__device__ __forceinline__ float wave_sum(float v) {
#pragma unroll
    for (int o = 1; o < 64; o <<= 1) v += __shfl_xor(v, o);
    return v;
}
__device__ __forceinline__ float gelu_tanh(float x) { const float u = 0.7978845608028654f * (x + 0.044715f * x * x * x); return x * __builtin_amdgcn_rcpf(1.0f + __expf(-2.0f * u)); }

__device__ __forceinline__ int win_col_map(int n) { return n < 5632 ? n : (n < 6144 ? n + 16 : (n < 6160 ? n - 512 : -1)); }
__device__ __forceinline__ void transpose_load(f32x4 (&v)[8], const float* W, int N, int nNew, bool remap, int item, int lane) {
    const int nblk = nNew / 32, kb = item / nblk, nb = item % nblk, k0 = 64 * kb, n0 = 32 * nb;
    const int n4 = (lane & 7) * 4, kr = lane >> 3; const int nn = n0 + n4; const int oc = remap ? win_col_map(nn) : nn;
#pragma unroll
    for (int i = 0; i < 8; ++i) v[i] = __builtin_nontemporal_load((const f32x4*)(W + (size_t)(k0 + i * 8 + kr) * N + (oc >= 0 ? oc : 0)));
}
__device__ __forceinline__ void transpose_finish(const f32x4 (&v)[8], int K, bf16_t* WT, int nNew, bool remap, float* scr, int item, int lane) {
    const int nblk = nNew / 32, kb = item / nblk, nb = item % nblk, k0 = 64 * kb, n0 = 32 * nb;
    const int n4 = (lane & 7) * 4, kr = lane >> 3; const bool ok = !remap || win_col_map(n0 + n4) >= 0;
#pragma unroll
    for (int i = 0; i < 8; ++i) *(f32x4*)(scr + (i * 8 + kr) * 36 + n4) = ok ? v[i] : (f32x4){0.f, 0.f, 0.f, 0.f};
    asm volatile("s_waitcnt lgkmcnt(0)" ::: "memory");
    const int c = lane & 7;
#pragma unroll
    for (int j = 0; j < 4; ++j) { const int n = (lane >> 3) + 8 * j; const float* s = scr + (8 * c) * 36 + n;
        u32x4 o; o.x = pk2(s[0 * 36], s[1 * 36]); o.y = pk2(s[2 * 36], s[3 * 36]); o.z = pk2(s[4 * 36], s[5 * 36]); o.w = pk2(s[6 * 36], s[7 * 36]);
        *(u32x4*)(WT + (size_t)(n0 + n) * K + k0 + 8 * c) = o; }
    asm volatile("s_waitcnt lgkmcnt(0)" ::: "memory");
}
constexpr int WT_IN = 32 * (NPROJ / 32), WT_OUT = 32 * (DM / 32), WT_GL = 8 * 16, WT_ITEMS = WT_IN + WT_OUT + WT_GL;
struct WtItem { const float* W; bf16_t* WT; int K, N, nNew, item; bool remap; };
__device__ __forceinline__ WtItem wt_item(const Params& p, int it) {
    unsigned char* ws = p.ws; const int l = it / WT_ITEMS; int r = it % WT_ITEMS; WtItem w;
    if (r < WT_IN) { w.W = p.in[I_WIN] + (size_t)l * DM * NCOL_IN; w.WT = (bf16_t*)(ws + W_WIN + l * SZ_WIN); w.K = DM; w.N = NCOL_IN; w.nNew = NPROJ; w.item = r; w.remap = true; return w; } r -= WT_IN;
    if (r < WT_OUT) { w.W = p.in[I_WOUT] + (size_t)l * DM * DM; w.WT = (bf16_t*)(ws + W_WOUT + l * SZ_WOUT); w.K = DM; w.N = DM; w.nNew = DM; w.item = r; w.remap = false; return w; } r -= WT_OUT;
    w.W = p.in[I_WGLU] + (size_t)l * 512 * 512; w.WT = (bf16_t*)(ws + W_WGLU + l * SZ_WGLU); w.K = 512; w.N = 512; w.nNew = 512; w.item = r; w.remap = false; return w;
}
__device__ __forceinline__ void p0_prologue(const Params& p, char* lds, int G) {
    unsigned char* ws = p.ws;
    int tid_o = threadIdx.x; asm volatile("" : "+v"(tid_o)); const int tid = tid_o, lane = tid & 63, wave = tid >> 6;
    const int gw = blockIdx.x * 8 + wave, NGW = G * 8;
    const int gt = blockIdx.x * NTHR + tid, NGT = G * NTHR;
    {
        float* act = (float*)lds;
        float* part = (float*)(ws + W_ADAP);
        for (int it = blockIdx.x; it < 256; it += G) {
            const int l = it >> 7, ks = it & 127;
            __syncthreads();
            if (tid < 48) { const int v = tid >> 4, kk = tid & 15, k = ks * 16 + kk; const float cv = (v < 2) ? p.in[I_C][v * DM + k] : p.in[I_CCTX][k]; act[tid] = silu(cv); }
            __syncthreads();
            const float* W = p.in[I_ADAW] + (size_t)l * DM * 6144 + (size_t)(ks * 16) * 6144 + 4 * tid;
            f32x4 a[3][3];
#pragma unroll
            for (int v = 0; v < 3; ++v)
#pragma unroll
                for (int j = 0; j < 3; ++j) a[v][j] = (f32x4){0.f, 0.f, 0.f, 0.f};
#pragma unroll
            for (int kk = 0; kk < 16; ++kk) {
                const float a0 = act[kk], a1 = act[16 + kk], a2 = act[32 + kk];
#pragma unroll
                for (int j = 0; j < 3; ++j) { const f32x4 w = __builtin_nontemporal_load((const f32x4*)(W + (size_t)kk * 6144 + 2048 * j)); a[0][j] += w * a0; a[1][j] += w * a1; a[2][j] += w * a2; }
            }
            float* po = part + (size_t)((l * 128 + ks) * 3) * 6144 + 4 * tid;
#pragma unroll
            for (int v = 0; v < 3; ++v)
#pragma unroll
                for (int j = 0; j < 3; ++j) *(f32x4*)(po + (size_t)v * 6144 + 2048 * j) = a[v][j];
        }
        __syncthreads();
    }
    {
        float* scr = (float*)(lds + wave * 9216);
        f32x4 v[8], vn[8];
        int it = gw;
        if (it < 2 * WT_ITEMS) { const WtItem w = wt_item(p, it); transpose_load(v, w.W, w.N, w.nNew, w.remap, w.item, lane); asm volatile("" :: "v"(v[7]), "v"(v[0])); }
        for (; it < 2 * WT_ITEMS; it += NGW) {
            const int nit = (it + NGW < 2 * WT_ITEMS) ? it + NGW : it;
            { const WtItem wn = wt_item(p, nit); transpose_load(vn, wn.W, wn.N, wn.nNew, wn.remap, wn.item, lane); }
            const WtItem w = wt_item(p, it); transpose_finish(v, w.K, w.WT, w.nNew, w.remap, scr, w.item, lane);
#pragma unroll
            for (int i = 0; i < 8; ++i) v[i] = vn[i];
        }
    }
    for (int idx16 = gt; idx16 < 2 * 2 * 32 * 64 * 16; idx16 += NGT) {
        const int j = idx16 & 15, idx = idx16 >> 4;
        const int n = idx & 63, g = (idx >> 6) & 31, dir = (idx >> 11) & 1, l = idx >> 12;
        const int ld = l * 2 + dir;
        const float a_re = p.in[I_ARE][(ld * 32 + g) * 64 + n], a_im = p.in[I_AIM][(ld * 32 + g) * 64 + n];
        const float dt = expf(p.in[I_LOGDT][ld * 32 + g]);
        const float mag = expf(a_re * dt); const float lam_re = mag * cosf(a_im * dt), lam_im = mag * sinf(a_im * dt);
        const float inv = 1.0f / (a_re * a_re + a_im * a_im);
        const float nr = lam_re - 1.0f, ni = lam_im;
        const float f_re = (nr * a_re + ni * a_im) * inv, f_im = (ni * a_re - nr * a_im) * inv;
        if (j == 0) {
            float* LAM = (float*)(ws + W_LAM); float* LAMT = (float*)(ws + W_LAMT);
            LAM[idx * 2] = lam_re; LAM[idx * 2 + 1] = lam_im;
            const double are = (double)a_re * (double)dt * 128.0, aim = (double)a_im * (double)dt * 128.0; const double mg = exp(are);
            LAMT[idx * 2] = (float)(mg * cos(aim)); LAMT[idx * 2 + 1] = (float)(mg * sin(aim));
        }
        float* BBT = (float*)(ws + W_BBT) + (size_t)((ld * 32 + g) * 128) * 16;
        { const int q = j; const float br = p.in[I_BRE][((l * 32 + g) * 16 + q) * 64 + n], bi = p.in[I_BIM][((l * 32 + g) * 16 + q) * 64 + n];
            BBT[n * 16 + q] = f_re * br - f_im * bi; BBT[(64 + n) * 16 + q] = f_re * bi + f_im * br; }
        float* CMT = (float*)(ws + W_CMT) + (size_t)((ld * 32 + g) * 16) * 128;
        { const int pp = j; const float cr = p.in[I_CRE][((ld * 32 + g) * 16 + pp) * 64 + n], ci = p.in[I_CIM][((ld * 32 + g) * 16 + pp) * 64 + n];
            CMT[pp * 128 + n] = cr; CMT[pp * 128 + 64 + n] = -ci; }
    }
    if (blockIdx.x == 0 && tid < 2) { const float* qw = p.in[I_QNORM] + tid * 128; const float* kw = p.in[I_KNORM] + tid * 128; float mq = 0.f, mk = 0.f;
        for (int i = 0; i < 128; ++i) { mq = fmaxf(mq, fabsf(qw[i])); mk = fmaxf(mk, fabsf(kw[i])); }
        ((float*)(ws + W_MISC))[tid] = -fminf((128.0f * 0.088388347648318440f * 1.4426950408889634f * 1.02f) * mq * mk, 64.0f); }
    for (int idx = gt; idx < SEQ * 64; idx += NGT) {
        const int t = idx >> 6, d = idx & 63; const float inv = exp2f(-(float)(d & 31) * (13.287712379549449f / 32.0f));
        const float pos = (d < 32) ? (float)(t >> 6) : (float)(t & 63); const float ang = pos * inv;
        float* RP = (float*)(ws + W_ROPE); RP[idx * 2] = cosf(ang); RP[idx * 2 + 1] = sinf(ang);
    }
}
__device__ __forceinline__ void p0b_ada(const Params& p, int G) {
    int tid_o = threadIdx.x; asm volatile("" : "+v"(tid_o)); const int gt = blockIdx.x * NTHR + tid_o, NGT = G * NTHR;
    const float* part = (const float*)(p.ws + W_ADAP); float* ada = (float*)(p.ws + W_ADA);
    for (int idx = gt; idx < 2 * 3 * 6144; idx += NGT) {
        const int l = idx / 18432, v = (idx / 6144) % 3, j = idx % 6144;
        float s = p.in[I_ADAB][l * 6144 + j];
#pragma unroll 16
        for (int ks = 0; ks < 128; ++ks) s += part[(size_t)((l * 128 + ks) * 3 + v) * 6144 + j];
        ada[idx] = s;
    }
}
struct XnRow { const float* src; const bf16_t* dl; };
__device__ __forceinline__ XnRow xn_src(const Params& p, int layer, int row) {
    const int b = row / RB, r = row % RB; const bool isc = r < CTX; XnRow x; x.dl = nullptr;
    if (isc) x.src = (layer == 0 ? p.in[I_CTX] : (const float*)(p.ws + W_HCTX)) + (size_t)(b * CTX + r) * DM;
    else { x.src = p.in[I_X] + (size_t)(b * SEQ + r - CTX) * DM; if (layer == 1) x.dl = (const bf16_t*)p.out + (size_t)(b * SEQ + r - CTX) * (2 * DM); }
    return x;
}
__device__ __forceinline__ void xn_load(f32x4 (&v)[8], u32x2 (&d)[8], const XnRow& x, int lane) {
#pragma unroll
    for (int j = 0; j < 8; ++j) { v[j] = __builtin_nontemporal_load((const f32x4*)(x.src + 4 * lane + 256 * j)); d[j] = x.dl ? __builtin_nontemporal_load((const u32x2*)(x.dl + 4 * lane + 256 * j)) : (u32x2){0u, 0u}; }
}
__device__ __forceinline__ void p1_xn(const Params& p, int layer, int G) {
    int tid_o = threadIdx.x; asm volatile("" : "+v"(tid_o)); const int tid = tid_o, lane = tid & 63, wave = tid >> 6; const int gw = blockIdx.x * 8 + wave, NGW = G * 8;
    const float* ada = (const float*)(p.ws + W_ADA) + layer * 3 * 6144; const float* nw = p.in[I_NORMW] + layer * DM;
    bf16_t* XN = (bf16_t*)(p.ws + W_XN);
    f32x4 w[8];
#pragma unroll
    for (int j = 0; j < 8; ++j) w[j] = *(const f32x4*)(nw + 4 * lane + 256 * j);
    f32x4 v[8], vn[8]; u32x2 d[8], dn[8];
    int row = gw;
    if (row < NROWS) xn_load(v, d, xn_src(p, layer, row), lane);
    for (; row < NROWS; row += NGW) {
        const int nrow = row + NGW;
        if (nrow < NROWS) xn_load(vn, dn, xn_src(p, layer, nrow), lane);
        const int b = row / RB, r = row % RB; const bool isc = r < CTX;
        const float* av = ada + (isc ? 2 : b) * 6144;
        f32x4 sh[8], sc[8];
#pragma unroll
        for (int j = 0; j < 8; ++j) { sh[j] = *(const f32x4*)(av + 4 * lane + 256 * j); sc[j] = *(const f32x4*)(av + 2048 + 4 * lane + 256 * j); }
        float ss = 0.f;
#pragma unroll
        for (int j = 0; j < 8; ++j) { v[j].x += lo16(d[j].x); v[j].y += hi16(d[j].x); v[j].z += lo16(d[j].y); v[j].w += hi16(d[j].y);
            ss += (v[j].x * v[j].x + v[j].y * v[j].y) + (v[j].z * v[j].z + v[j].w * v[j].w); }
        const float rstd = rsqrtf(wave_sum(ss) * (1.0f / DM) + EPSN);
#pragma unroll
        for (int j = 0; j < 8; ++j) { const int c = 4 * lane + 256 * j;
            const f32x4 y = (v[j] * rstd * w[j]) * (sc[j] + 1.0f) + sh[j];
            u32x2 o; o.x = pk2(y.x, y.y); o.y = pk2(y.z, y.w); *(u32x2*)(XN + (size_t)row * DM + c) = o; }
#pragma unroll
        for (int j = 0; j < 8; ++j) { v[j] = vn[j]; d[j] = dn[j]; }
    }
}
__device__ __forceinline__ void p_final(const Params& p, int G) {
    int tid_o = threadIdx.x; asm volatile("" : "+v"(tid_o)); const int tid = tid_o, lane = tid & 63, wave = tid >> 6; const int gw = blockIdx.x * 8 + wave, NGW = G * 8;
    const float* nw = p.in[I_FNORM]; const bf16_t* D1 = (const bf16_t*)(p.ws + W_PROJ); const bf16_t* D0 = (const bf16_t*)p.out;
    f32x4 w[8];
#pragma unroll
    for (int j = 0; j < 8; ++j) w[j] = *(const f32x4*)(nw + 4 * lane + 256 * j);
    f32x4 v[8], vn[8]; u32x2 d0[8], d0n[8], d1[8], d1n[8];
    int row = gw;
    if (row < NBATCH * SEQ) {
#pragma unroll
        for (int j = 0; j < 8; ++j) { const int c = 4 * lane + 256 * j; v[j] = __builtin_nontemporal_load((const f32x4*)(p.in[I_X] + (size_t)row * DM + c)); d0[j] = __builtin_nontemporal_load((const u32x2*)(D0 + (size_t)row * (2 * DM) + c)); d1[j] = __builtin_nontemporal_load((const u32x2*)(D1 + (size_t)row * DM + c)); } }
    for (; row < NBATCH * SEQ; row += NGW) {
        const int nrow = row + NGW;
        if (nrow < NBATCH * SEQ) {
#pragma unroll
            for (int j = 0; j < 8; ++j) { const int c = 4 * lane + 256 * j; vn[j] = __builtin_nontemporal_load((const f32x4*)(p.in[I_X] + (size_t)nrow * DM + c)); d0n[j] = __builtin_nontemporal_load((const u32x2*)(D0 + (size_t)nrow * (2 * DM) + c)); d1n[j] = __builtin_nontemporal_load((const u32x2*)(D1 + (size_t)nrow * DM + c)); } }
        float ss = 0.f;
#pragma unroll
        for (int j = 0; j < 8; ++j) { v[j].x += lo16(d0[j].x) + lo16(d1[j].x); v[j].y += hi16(d0[j].x) + hi16(d1[j].x); v[j].z += lo16(d0[j].y) + lo16(d1[j].y); v[j].w += hi16(d0[j].y) + hi16(d1[j].y);
            ss += (v[j].x * v[j].x + v[j].y * v[j].y) + (v[j].z * v[j].z + v[j].w * v[j].w); }
        const float rstd = rsqrtf(wave_sum(ss) * (1.0f / DM) + EPSN);
        float* dst = p.out + (size_t)row * DM;
#pragma unroll
        for (int j = 0; j < 8; ++j) __builtin_nontemporal_store(v[j] * rstd * w[j], (f32x4*)(dst + 4 * lane + 256 * j));
#pragma unroll
        for (int j = 0; j < 8; ++j) { v[j] = vn[j]; d0[j] = d0n[j]; d1[j] = d1n[j]; }
    }
}
constexpr float ATT_QSCALE = 0.088388347648318440f * 1.4426950408889634f;
struct NrLoad { u32x4 a, b; f32x4 r0, r1, r2, r3; };
__device__ __forceinline__ void nr_load(NrLoad& L, const bf16_t* ptr, const float* RP, int t, int d0) {
    L.a = *(const u32x4*)(ptr + d0); L.b = *(const u32x4*)(ptr + 64 + d0);
    const float* rp = RP + ((size_t)(t < 0 ? 0 : t) * 64 + d0) * 2;
    L.r0 = *(const f32x4*)rp; L.r1 = *(const f32x4*)(rp + 4); L.r2 = *(const f32x4*)(rp + 8); L.r3 = *(const f32x4*)(rp + 12);
}
__device__ __forceinline__ void nr_finish(const NrLoad& L, bf16_t* ptr, bool isc, int d0, const f32x4 (&w)[4], float osc) {
    float x1[8], x2[8]; float ss = 0.f;
#pragma unroll
    for (int i = 0; i < 4; ++i) { x1[2 * i] = lo16(L.a[i]); x1[2 * i + 1] = hi16(L.a[i]); x2[2 * i] = lo16(L.b[i]); x2[2 * i + 1] = hi16(L.b[i]); }
#pragma unroll
    for (int i = 0; i < 8; ++i) ss += x1[i] * x1[i] + x2[i] * x2[i];
    ss += __shfl_xor(ss, 1); ss += __shfl_xor(ss, 2); ss += __shfl_xor(ss, 4);
    const float rstd = rsqrtf(ss * (1.0f / 128.0f) + EPSN);
    const float cs[8] = {L.r0.x, L.r0.z, L.r1.x, L.r1.z, L.r2.x, L.r2.z, L.r3.x, L.r3.z}, sn[8] = {L.r0.y, L.r0.w, L.r1.y, L.r1.w, L.r2.y, L.r2.w, L.r3.y, L.r3.w};
    float o1[8], o2[8];
#pragma unroll
    for (int i = 0; i < 8; ++i) { const float y1 = x1[i] * rstd * w[i >> 2][i & 3], y2 = x2[i] * rstd * w[2 + (i >> 2)][i & 3];
        const float c = isc ? 1.0f : cs[i], s = isc ? 0.0f : sn[i]; o1[i] = (y1 * c - y2 * s) * osc; o2[i] = (y1 * s + y2 * c) * osc; }
    u32x4 wa, wb;
#pragma unroll
    for (int i = 0; i < 4; ++i) { wa[i] = pk2(o1[2 * i], o1[2 * i + 1]); wb[i] = pk2(o2[2 * i], o2[2 * i + 1]); }
    *(u32x4*)(ptr + d0) = wa; *(u32x4*)(ptr + 64 + d0) = wb;
}
constexpr int GM_PITCH = DM * 2 + 16;
__device__ __forceinline__ void gates_mfma(const Params& p, int layer, int bxv, int Gv, char* ldsc) {
    unsigned char* ws = p.ws; LAS unsigned char* lds = (LAS unsigned char*)ldsc;
    const bf16_t* XN = (const bf16_t*)(ws + W_XN); const bf16_t* WgT = (const bf16_t*)(ws + W_WIN + layer * SZ_WIN) + (size_t)6144 * DM;
    const float* gb = p.in[I_GATEB] + layer * 16; float* gd = (float*)(ws + W_GD);
    int tid_o = threadIdx.x; asm volatile("" : "+v"(tid_o)); const int tid = tid_o, lane = tid & 63, wave = tid >> 6, fr = lane & 15, fq = lane >> 4;
    __syncthreads();
#pragma unroll
    for (int q = 0; q < 8; ++q) { const int c = tid + q * NTHR; const int r = c >> 8, k8 = (c & 255) * 8;
        *(LAS u32x4*)(lds + r * GM_PITCH + k8 * 2) = *(const u32x4*)(WgT + (size_t)r * DM + k8); }
    __syncthreads();
    const f32x4 bias = *(const f32x4*)(gb + 4 * fq); const bool isf = (fq & 1) != 0;
    for (int tile = wave * Gv + (Gv - 1 - bxv); tile < NROWS / 16; tile += Gv * 8) {
        const bf16_t* Ab = XN + (size_t)(tile * 16 + fr) * DM + 8 * fq; unsigned boff = fr * GM_PITCH + 16 * fq; asm volatile("" : "+v"(boff));
        const LAS unsigned char* Bb = lds + boff;
        f32x4 acc = {0.f, 0.f, 0.f, 0.f};
        bf16x8 a0[8], a1[8], a2[8];
#define GM_LOAD(A, KB) do { _Pragma("unroll") for (int s = 0; s < 8; ++s) A[s] = *(const bf16x8*)(Ab + ((KB) * 8 + s) * 32); } while (0)
#define GM_MMA(A, KB) do { _Pragma("unroll") for (int s = 0; s < 8; ++s) { const bf16x8 b = *(const LAS bf16x8*)(Bb + ((KB) * 8 + s) * 64); acc = __builtin_amdgcn_mfma_f32_16x16x32_bf16(b, A[s], acc, 0, 0, 0); } } while (0)
        GM_LOAD(a0, 0); GM_LOAD(a1, 1); GM_LOAD(a2, 2);
        GM_MMA(a0, 0); GM_LOAD(a0, 3);
        GM_MMA(a1, 1); GM_LOAD(a1, 4);
        GM_MMA(a2, 2); GM_LOAD(a2, 5);
        GM_MMA(a0, 3); GM_LOAD(a0, 6);
        GM_MMA(a1, 4); GM_LOAD(a1, 7);
        GM_MMA(a2, 5); GM_MMA(a0, 6); GM_MMA(a1, 7);
#undef GM_LOAD
#undef GM_MMA
        f32x4 y;
#pragma unroll
        for (int rg = 0; rg < 4; ++rg) { const float x = acc[rg] + bias[rg]; y[rg] = isf ? (fminf(x, 0.f) - log1pf(__expf(-fabsf(x)))) : x; }
        *(f32x4*)(gd + (size_t)(tile * 16 + fr) * 16 + 4 * fq) = y;
    }
}
__device__ __forceinline__ void p3_post(const Params& p, int layer, int G) {
    unsigned char* ws = p.ws;
    int tid_o = threadIdx.x; asm volatile("" : "+v"(tid_o)); const int tid = tid_o, lane = tid & 63, wave = tid >> 6;
    const int gw = blockIdx.x * 8 + wave, NGW = G * 8;
    const int gt = blockIdx.x * NTHR + tid, NGT = G * NTHR;
    bf16_t* PROJ = (bf16_t*)(ws + W_PROJ);
    const float* RP = (const float*)(ws + W_ROPE);
    const int d0 = (lane & 7) * 8;
    {
        bf16_t* ATK = PROJ + (size_t)NROWS * SEC_ATK; const float* knw = p.in[I_KNORM] + layer * 128;
        f32x4 w[4]; w[0] = *(const f32x4*)(knw + d0); w[1] = *(const f32x4*)(knw + d0 + 4); w[2] = *(const f32x4*)(knw + 64 + d0); w[3] = *(const f32x4*)(knw + 64 + d0 + 4);
        const int hd = (lane >> 3) & 1, rs = lane >> 4;
        for (int rq = gw; rq < NROWS / 4; rq += 3 * NGW) {
            NrLoad L[3]; bf16_t* ptr[3]; bool isc[3]; bool ok[3];
#pragma unroll
            for (int q = 0; q < 3; ++q) { const int r4 = rq + q * NGW; ok[q] = r4 < NROWS / 4; const int r2 = (ok[q] ? r4 : rq) * 4 + rs; const int r = r2 % RB; isc[q] = r < CTX;
                ptr[q] = ATK + (size_t)r2 * 256 + hd * 128; nr_load(L[q], ptr[q], RP, r - CTX, d0); }
#pragma unroll
            for (int q = 0; q < 3; ++q) if (ok[q]) nr_finish(L[q], ptr[q], isc[q], d0, w, 1.0f);
        }
    }
    {
        const bf16_t* MLQ = PROJ + (size_t)NROWS * SEC_MLQ; const bf16_t* MLK = PROJ + (size_t)NROWS * SEC_MLK;
        bf16_t* CQ = (bf16_t*)(ws + W_CQ); bf16_t* CK = (bf16_t*)(ws + W_CK);
        const float* cw = p.in[I_CONVW] + layer * 3 * 1024; const float* cb = p.in[I_CONVB] + layer * 1024;
        for (int it = gw; it < 2048; it += NGW) {
            const int rb = it >> 2, quarter = it & 3; const int ch = quarter * 256 + lane * 4; const bool isk = quarter >= 2; const int cc = ch & 511;
            const f32x4 w0 = *(const f32x4*)(cw + ch), w1 = *(const f32x4*)(cw + 1024 + ch), w2 = *(const f32x4*)(cw + 2048 + ch), bb = *(const f32x4*)(cb + ch);
            const float osc = isk ? 0.08838834764831845f : 1.0f;
            const bf16_t* src = (isk ? MLK : MLQ) + cc; bf16_t* dst = (isk ? CK : CQ) + cc;
            const int r0 = rb * 33;
            u32x2 xv[35];
#pragma unroll
            for (int i = 0; i < 35; ++i) { const int r = r0 - 1 + i; xv[i] = (r >= 0 && r < NROWS) ? __builtin_nontemporal_load((const u32x2*)(src + (size_t)r * 512)) : (u32x2){0u, 0u}; }
#pragma unroll
            for (int i = 0; i < 33; ++i) { const int row = r0 + i; const int r = row % RB; const bool isc = r < CTX; const int t = isc ? r : r - CTX, len = isc ? CTX : SEQ;
                const u32x2 xp = (t > 0) ? xv[i] : (u32x2){0u, 0u}, xc = xv[i + 1], xn = (t < len - 1) ? xv[i + 2] : (u32x2){0u, 0u};
                float y0 = w0.x * lo16(xp.x) + w1.x * lo16(xc.x) + w2.x * lo16(xn.x) + bb.x, y1 = w0.y * hi16(xp.x) + w1.y * hi16(xc.x) + w2.y * hi16(xn.x) + bb.y;
                float y2 = w0.z * lo16(xp.y) + w1.z * lo16(xc.y) + w2.z * lo16(xn.y) + bb.z, y3 = w0.w * hi16(xp.y) + w1.w * hi16(xc.y) + w2.w * hi16(xn.y) + bb.w;
                u32x2 o; o.x = pk2(silu(y0) * osc, silu(y1) * osc); o.y = pk2(silu(y2) * osc, silu(y3) * osc);
                *(u32x2*)(dst + (size_t)row * 512) = o; }
        }
    }
}
__device__ __forceinline__ void p4_attn(const Params& p, int layer, int G, char* lds) {
    unsigned char* ws = p.ws; const bf16_t* PROJ = (const bf16_t*)(ws + W_PROJ); bf16_t* MIX = (bf16_t*)(ws + W_XN);
    const bf16_t* ATQ = PROJ + (size_t)NROWS * SEC_ATQ; const bf16_t* ATK = PROJ + (size_t)NROWS * SEC_ATK; const bf16_t* ATV = PROJ + (size_t)NROWS * SEC_ATV; const bf16_t* ATZ = PROJ + (size_t)NROWS * SEC_ATZ;
    const int bx = blockIdx.x; const int vcu = (G % 8 == 0) ? (bx % 8) * (G / 8) + bx / 8 : bx;
    const int nunits = 512 + (layer == 0 ? 16 : 0);
    for (int u = vcu; u < nunits; u += G) {
        int b, h, rowq, seq;
        if (u < 512) { const int combo = u >> 7, within = u & 127; b = combo >> 1; const int kvh = combo & 1; h = kvh * 4 + (within >> 5); const int qb = within & 31; rowq = b * RB + CTX + qb * 256; seq = RB; }
        else { const int v = u - 512; b = v >> 3; h = v & 7; rowq = b * RB; seq = CTX; }
        const int kvh = h >> 2; const size_t key0 = (size_t)b * RB; const float negmv = ((const float*)(ws + W_MISC))[layer];
        attn::attn_dense_body(ATQ + (size_t)rowq * 1024 + h * 128, ATK + key0 * 256 + kvh * 128, ATV + key0 * 256 + kvh * 128,
                              ATZ + (size_t)rowq * 1024 + h * 128, MIX + (size_t)rowq * 2048 + 512 + h * 128, seq, negmv, lds, p.in[I_QNORM] + layer * 128,
                              (u < 512) ? (const float*)(ws + W_ROPE) + (size_t)(rowq - b * RB - CTX) * 128 : (const float*)nullptr);
    }
}
__device__ __forceinline__ int chunk_at(int dir, int pos) { return dir == 0 ? pos : (pos < 2 ? 1 - pos : 67 - pos); }
constexpr int S5_XS = 12  , S5_XB = 128 * S5_XS  , S5_SS = 16  , S5_WAVE_LDS = 2 * S5_XB * 4 + 128 * S5_SS * 2;
typedef short v4i16_t __attribute__((ext_vector_type(4)));
__device__ __forceinline__ v4i16_t lds_tr16(const LAS void* p) { return __builtin_amdgcn_ds_read_tr16_b64_v4i16((LAS v4i16_t*)p); }
typedef short bf16x4 __attribute__((ext_vector_type(4)));
constexpr int S5_XS2 = 20;
struct S5C { bf16x4 bfx[8]; bf16x8 afy[4]; f32x2_t l1, l2; };
__device__ __forceinline__ f32x2_t pkfma(f32x2_t a, f32x2_t b, f32x2_t c) { f32x2_t d; asm("v_pk_fma_f32 %0, %1, %2, %3" : "=v"(d) : "v"(a), "v"(b), "v"(c)); return d; }
__device__ __forceinline__ f32x2_t pkfma_sw(f32x2_t a, f32x2_t b, f32x2_t c) { f32x2_t d; asm("v_pk_fma_f32 %0, %1, %2, %3 op_sel:[0,1,0] op_sel_hi:[1,0,1]" : "=v"(d) : "v"(a), "v"(b), "v"(c)); return d; }
template <bool PASS2>
__device__ __forceinline__ void s5_load_consts(S5C& c, const float* lam, const float* bbt, const float* cmt, int lane) {
    const int fr = lane & 15, fq = lane >> 4;
#pragma unroll
    for (int ct = 0; ct < 8; ++ct) {
        const f32x4 v = *(const f32x4*)(bbt + (ct * 16 + fr) * 16 + 4 * fq);
        u32x2 w; w.x = pk2(v[0], v[1]); w.y = pk2(v[2], v[3]); c.bfx[ct] = __builtin_bit_cast(bf16x4, w);
    }
    if (PASS2) {
#pragma unroll
        for (int kk = 0; kk < 4; ++kk) { const f32x8 v = *(const f32x8*)(cmt + fr * 128 + kk * 32 + 8 * fq);
            u32x4 w; w.x = pk2(v[0], v[1]); w.y = pk2(v[2], v[3]); w.z = pk2(v[4], v[5]); w.w = pk2(v[6], v[7]); c.afy[kk] = __builtin_bit_cast(bf16x8, w); }
    }
    { const float lr = lam[2 * lane], li = lam[2 * lane + 1]; c.l1 = (f32x2_t){lr, lr}; c.l2 = (f32x2_t){-li, li}; }
}
__device__ __forceinline__ void s5_load_u(bf16x4 (&au)[8], const bf16_t* U, int lane) {
    const int fr = lane & 15, fq = lane >> 4;
#pragma unroll
    for (int s_ = 0; s_ < 8; ++s_) au[s_] = *(const bf16x4*)(U + (size_t)(s_ * 16 + fr) * 512 + 4 * fq);
}
template <int DIR, bool PASS2>
__device__ __forceinline__ void s5_chunk_dir(const bf16x4 (&au)[8], const S5C& c, f32x2_t& S, f32x4 (&yacc)[8], LAS float* Xsf, LAS bf16_t* Ss, int lane) {
    const int fr = lane & 15, fq = lane >> 4;
    const f32x2_t l1 = c.l1, l2 = c.l2;
    LAS unsigned* Xs = (LAS unsigned*)Xsf;
    const LAS unsigned char* trb = (const LAS unsigned char*)Ss + ((8 * fq + (fr >> 2)) * S5_SS + 4 * (fr & 3)) * 2;
#define S5_STAGE(SLAB, BUF) do { _Pragma("unroll") for (int ct = 0; ct < 4; ++ct) { \
        const f32x4 xr = __builtin_amdgcn_mfma_f32_16x16x16bf16_1k(au[SLAB], c.bfx[ct], (f32x4){0.f, 0.f, 0.f, 0.f}, 0, 0, 0);       \
        const f32x4 xi = __builtin_amdgcn_mfma_f32_16x16x16bf16_1k(au[SLAB], c.bfx[ct + 4], (f32x4){0.f, 0.f, 0.f, 0.f}, 0, 0, 0);   \
        u32x4 xw; xw.x = pk2(xr[0], xi[0]); xw.y = pk2(xr[1], xi[1]); xw.z = pk2(xr[2], xi[2]); xw.w = pk2(xr[3], xi[3]); *(LAS u32x4*)(Xs + (BUF) * S5_XB + (ct * 16 + fr) * S5_XS2 + 4 * fq) = xw; } } while (0)
#define S5_FETCH(XW, BUF) do { _Pragma("unroll") for (int j = 0; j < 4; ++j) XW[j] = *(const LAS u32x4*)(Xs + (BUF) * S5_XB + lane * S5_XS2 + 4 * j); } while (0)
#define S5_YMMA(SLAB) do { _Pragma("unroll") for (int kk = 0; kk < 4; ++kk) { \
        const v4i16_t lo = lds_tr16(trb + (kk * 32) * S5_SS * 2), hi = lds_tr16(trb + (kk * 32 + 4) * S5_SS * 2); \
        const bf16x8 bs = (bf16x8){lo[0], lo[1], lo[2], lo[3], hi[0], hi[1], hi[2], hi[3]};     \
        yacc[SLAB] = __builtin_amdgcn_mfma_f32_16x16x32_bf16(c.afy[kk], bs, yacc[SLAB], 0, 0, 0); } } while (0)
    u32x4 xw[4], xn[4];
    S5_STAGE(DIR ? 7 : 0, 0); S5_FETCH(xw, 0);
#pragma unroll
    for (int s_ = 0; s_ < 8; ++s_) {
        const int slabn = DIR ? 6 - s_ : s_ + 1, slabp = DIR ? 8 - s_ : s_ - 1;
        if (s_ + 1 < 8) { S5_STAGE(slabn, (s_ + 1) & 1); S5_FETCH(xn, (s_ + 1) & 1); }
        if (PASS2 && s_ > 0) S5_YMMA(slabp);
        f32x2_t so[16];
#pragma unroll
        for (int tt = 0; tt < 16; ++tt) {
            const int t = DIR ? 15 - tt : tt;
            const unsigned w_ = xw[t >> 2][t & 3]; const f32x2_t xv = (f32x2_t){lo16(w_), hi16(w_)};
            S = pkfma_sw(l2, S, pkfma(l1, S, xv));
            so[t] = S;
        }
        if (PASS2) {
            u32x4 w0, w1, w2, w3;
#pragma unroll
            for (int j = 0; j < 4; ++j) { w0[j] = pk2(so[2 * j].x, so[2 * j + 1].x); w1[j] = pk2(so[8 + 2 * j].x, so[9 + 2 * j].x); w2[j] = pk2(so[2 * j].y, so[2 * j + 1].y); w3[j] = pk2(so[8 + 2 * j].y, so[9 + 2 * j].y); }
            *(LAS u32x4*)(Ss + lane * S5_SS) = w0; *(LAS u32x4*)(Ss + lane * S5_SS + 8) = w1;
            *(LAS u32x4*)(Ss + (64 + lane) * S5_SS) = w2; *(LAS u32x4*)(Ss + (64 + lane) * S5_SS + 8) = w3;
        }
        if (s_ + 1 < 8) {
#pragma unroll
            for (int j = 0; j < 4; ++j) xw[j] = xn[j]; }
    }
    if (PASS2) S5_YMMA(DIR ? 0 : 7);
    asm volatile("s_waitcnt lgkmcnt(0)" ::: "memory");
#undef S5_STAGE
#undef S5_FETCH
#undef S5_YMMA
}
__device__ __forceinline__ void s5_pass1(const Params& p, int layer, int G, char* lds, int bx) {
    unsigned char* ws = p.ws; int tid_o = threadIdx.x; asm volatile("" : "+v"(tid_o)); const int tid = tid_o, lane = tid & 63, wave = tid >> 6; const int gw = bx * 8 + wave, NGW = G * 8;
    LAS float* Xs = (LAS float*)((LAS unsigned char*)lds + wave * S5_WAVE_LDS); LAS bf16_t* Ss = (LAS bf16_t*)((LAS unsigned char*)lds + wave * S5_WAVE_LDS + 2 * S5_XB * 4);
    const bf16_t* S5U = (const bf16_t*)(ws + W_PROJ) + (size_t)NROWS * SEC_S5U; float* F = (float*)(ws + W_S5F);
    const int g = gw & 31, dir = (gw >> 5) & 1, b = (gw >> 6) & 1, kb = gw >> 7; const int kstep = NGW >> 7;
    if (b >= NBATCH || kstep <= 0 || kb >= kstep) return;
    const int ld = layer * 2 + dir;
    S5C c; s5_load_consts<false>(c, (const float*)(ws + W_LAM) + (size_t)((ld * 32 + g) * 64) * 2, (const float*)(ws + W_BBT) + (size_t)((ld * 32 + g) * 128) * 16,
                                 (const float*)(ws + W_CMT) + (size_t)((ld * 32 + g) * 16) * 128, lane);
    bf16x4 au[8], aun[8];
    if (kb < NCH) s5_load_u(au, S5U + (size_t)(b * RB + kb * 128) * 512 + g * 16, lane);
    for (int k = kb; k < NCH; k += kstep) {
        { const int kn = (k + kstep < NCH) ? k + kstep : k; s5_load_u(aun, S5U + (size_t)(b * RB + kn * 128) * 512 + g * 16, lane); }
        f32x2_t S = {0.f, 0.f}; f32x4 yacc[8];
        if (dir == 0) s5_chunk_dir<0, false>(au, c, S, yacc, Xs, Ss, lane);
        else          s5_chunk_dir<1, false>(au, c, S, yacc, Xs, Ss, lane);
        float* Fo = F + ((size_t)((b * 32 + g) * 2 + dir) * NCH + k) * 128;
        Fo[lane] = S.x; Fo[64 + lane] = S.y;
#pragma unroll
        for (int s_ = 0; s_ < 8; ++s_) au[s_] = aun[s_];
    }
}
__device__ __forceinline__ void s5_carry(const Params& p, int layer, int G) {
    unsigned char* ws = p.ws; int tid_o = threadIdx.x; asm volatile("" : "+v"(tid_o)); const int gt = (G - 1 - (int)blockIdx.x) * NTHR + tid_o, NGT = G * NTHR;
    float* F = (float*)(ws + W_S5F);
    for (int idx = gt; idx < 2 * 32 * 2 * 64; idx += NGT) {
        const int n = idx & 63, dir = (idx >> 6) & 1, g = (idx >> 7) & 31, b = idx >> 12;
        const float* lt = (const float*)(ws + W_LAMT) + (size_t)(((layer * 2 + dir) * 32 + g) * 64 + n) * 2;
        const float lr = lt[0], li = lt[1];
        float* Fb = F + (size_t)((b * 32 + g) * 2 + dir) * NCH * 128;
        float sr = 0.f, si = 0.f;
#pragma unroll 1
        for (int p0 = 0; p0 < NCH; p0 += 22) {
            float fr_[22], fi_[22];
#pragma unroll
            for (int q = 0; q < 22; ++q) { const int k = chunk_at(dir, p0 + q); fr_[q] = Fb[k * 128 + n]; fi_[q] = Fb[k * 128 + 64 + n]; }
#pragma unroll
            for (int q = 0; q < 22; ++q) { const int k = chunk_at(dir, p0 + q); Fb[k * 128 + n] = sr; Fb[k * 128 + 64 + n] = si;
                const float nr = lr * sr - li * si + fr_[q], ni = lr * si + li * sr + fi_[q]; sr = nr; si = ni; }
        }
    }
}
constexpr int M2_COEF_OFF = 8 * S5_WAVE_LDS;
__device__ __forceinline__ void s5_pass2(const Params& p, int layer, int G, char* lds) {
    unsigned char* ws = p.ws; int tid_o = threadIdx.x; asm volatile("" : "+v"(tid_o)); const int tid = tid_o, lane = tid & 63, wave = tid >> 6;
    float* STC = (float*)(ws + W_STC); float* STN = (float*)(ws + W_STN); float* STS = (float*)(ws + W_STS); unsigned* CBw = (unsigned*)(ws + W_CB);
    LAS float* coef = (LAS float*)((LAS unsigned char*)lds + M2_COEF_OFF);
    const int fr = lane & 15, fq = lane >> 4, dir = wave >> 2, pi = wave & 3;
    LAS float* Xs = (LAS float*)((LAS unsigned char*)lds + wave * S5_WAVE_LDS); LAS bf16_t* Ss = (LAS bf16_t*)((LAS unsigned char*)lds + wave * S5_WAVE_LDS + 2 * S5_XB * 4);
    LAS float* YX = (LAS float*)((LAS unsigned char*)lds + pi * S5_WAVE_LDS);
    bf16_t* S5U = (bf16_t*)(ws + W_PROJ) + (size_t)NROWS * SEC_S5U; const float* F = (const float*)(ws + W_S5F);
    const float* Dv = p.in[I_SSMD] + layer * 512;
    const int gp = blockIdx.x * 4 + pi, NGP = G * 4; const int g = gp & 31, b = (gp >> 5) & 1, kb = gp >> 6; const int kstep = NGP >> 6;
    const int ld = layer * 2 + dir;
    S5C c; s5_load_consts<true>(c, (const float*)(ws + W_LAM) + (size_t)((ld * 32 + g) * 64) * 2, (const float*)(ws + W_BBT) + (size_t)((ld * 32 + g) * 128) * 16,
                                (const float*)(ws + W_CMT) + (size_t)((ld * 32 + g) * 16) * 128, lane);
    const f32x4 dg = *(const f32x4*)(Dv + g * 16 + 4 * fq);
    const int nit = (kstep > 0) ? (NCH + kstep - 1) / kstep : 0;
    const float* Fd = F + (size_t)((b * 32 + g) * 2 + dir) * NCH * 128;
    bf16x4 au[8], aun[8]; f32x2_t Sc, Sn;
    { const int k0 = (nit > 0 && kb < NCH && !(layer == 1 && kb < 2)) ? kb : 2; s5_load_u(au, S5U + (size_t)(b * RB + k0 * 128) * 512 + g * 16, lane); Sc = (f32x2_t){Fd[k0 * 128 + lane], Fd[k0 * 128 + 64 + lane]}; }
    for (int i = tid; i < 16 * NCH; i += NTHR) { const int chain = i / NCH, k = i - chain * NCH, pos = chunk_at(chain & 1, k);
        *(LAS f32x2_t*)(coef + (chain * NCH + pos) * 2) = *(const f32x2_t*)(STS + (size_t)i * 4); }
    __syncthreads();
    if (tid < 16) { const int chain = tid, cdir = chain & 1; float* sb = STS + (size_t)chain * NCH * 4; float m = 0.f;
#pragma unroll 11
        for (int pos = 0; pos < NCH; ++pos) { const int k = chunk_at(cdir, pos); const f32x2_t ba = *(const LAS f32x2_t*)(coef + (chain * NCH + pos) * 2); if (blockIdx.x == 0) sb[k * 4 + 2] = m;
            const float mx = fmaxf(m, ba.y); *(LAS f32x2_t*)(coef + (chain * NCH + pos) * 2) = (f32x2_t){__expf(m - mx), __expf(ba.y - mx)}; m = ba.x + mx; } }
    __syncthreads();
    int tid2 = tid; asm volatile("" : "+v"(tid2));
    const int gt2 = blockIdx.x * NTHR + tid2; const bool m2on = gt2 < 16 * 8192;
    const int m2chain = (gt2 >> 13) & 15, m2dir = m2chain & 1; float m2c0 = 0.f, m2c1 = 0.f;
    const unsigned* m2base = (const unsigned*)STC + (size_t)m2chain * NCH * 8192 + (gt2 & 8191)  ; unsigned* m2cb = CBw + (size_t)m2chain * NCH * 8192 + (gt2 & 8191);
    if ((int)blockIdx.x >= G - 2) {
        const int nt = ((int)blockIdx.x - (G - 2)) * NTHR + tid2; const int n2chain = (nt >> 6) & 15, n2dir = n2chain & 1; float n2c0 = 0.f, n2c1 = 0.f; float* n2base = STN + (size_t)n2chain * NCH * 128 + 2 * (nt & 63);
#pragma unroll 1
        for (int nb = 0; nb < 3; ++nb) { f32x2_t nu[22]; int nbo = nb; asm volatile("" : "+s"(nbo));
#pragma unroll
            for (int q = 0; q < 22; ++q) { const int kk = chunk_at(n2dir, nbo * 22 + q); nu[q] = *(const f32x2_t*)(n2base + (size_t)kk * 128); }
#pragma unroll
            for (int q = 0; q < 22; ++q) { const int pos = nbo * 22 + q, kk = chunk_at(n2dir, pos); *(f32x2_t*)(n2base + (size_t)kk * 128) = (f32x2_t){n2c0, n2c1};
                const float f0 = coef[(n2chain * NCH + pos) * 2], f1 = coef[(n2chain * NCH + pos) * 2 + 1]; n2c0 = f0 * n2c0 + f1 * nu[q].x; n2c1 = f0 * n2c1 + f1 * nu[q].y; } }
    }
    for (int it = 0; it < nit || it < 6; ++it) {
        int lane_i = lane; asm volatile("" : "+v"(lane_i)); const int fr_i = lane_i & 15, fq_i = lane_i >> 4;
        unsigned m2u[11]; const int m2b = it; const bool m2act = m2on && it < 6;
        { const unsigned* lb = m2on ? m2base : (const unsigned*)STC; const int pb = it < 6 ? it * 11 : 0;
#pragma unroll
          for (int q = 0; q < 11; ++q) { const int kk = chunk_at(m2dir, pb + q); m2u[q] = lb[(size_t)kk * 8192]; } }
        const int k = kb + it * kstep; const bool act = (it < nit) && (k < NCH) && !(layer == 1 && k < 2);
        bf16_t* U = S5U + (size_t)(b * RB + (act ? k : 0) * 128) * 512 + g * 16;
        f32x4 yacc[8]; u32x2 uw[8];
#pragma unroll
        for (int s = 0; s < 8; ++s) yacc[s] = (f32x4){0.f, 0.f, 0.f, 0.f};
        { const int kn = k + kstep; const int knc = ((it + 1 < nit) && (kn < NCH) && !(layer == 1 && kn < 2)) ? kn : 2;
          s5_load_u(aun, S5U + (size_t)(b * RB + knc * 128) * 512 + g * 16, lane_i); Sn = (f32x2_t){Fd[knc * 128 + lane_i], Fd[knc * 128 + 64 + lane_i]}; }
        if (act) {
            f32x2_t S = Sc;
            if (dir == 0) s5_chunk_dir<0, true>(au, c, S, yacc, Xs, Ss, lane);
            else          s5_chunk_dir<1, true>(au, c, S, yacc, Xs, Ss, lane);
        }
        u32x2 uk[4];
#pragma unroll
        for (int s = 0; s < 4; ++s) { const u32x2 a0 = __builtin_bit_cast(u32x2, au[s]), a1 = __builtin_bit_cast(u32x2, au[4 + s]); uk[s].x = dir ? a1.x : a0.x; uk[s].y = dir ? a1.y : a0.y; }
#pragma unroll
        for (int s = 0; s < 8; ++s) { au[s] = aun[s]; asm volatile("" : "+v"(au[s])); }
        Sc = Sn; asm volatile("" : "+v"(Sc));
        __syncthreads();
        if (act) {
            LAS float* YO = (LAS float*)((LAS unsigned char*)lds + (wave ^ 4) * S5_WAVE_LDS);
            if (dir == 0) {
#pragma unroll
                for (int s = 0; s < 4; ++s) *(LAS f32x4*)(YO + (s * 64 + lane) * 4) = yacc[4 + s];
            } else {
#pragma unroll
                for (int s = 0; s < 4; ++s) *(LAS f32x4*)(YO + (s * 64 + lane) * 4) = yacc[s];
            }
        }
        __syncthreads();
#define S5_EPI(SL, S_) do { bf16_t* up = U + (size_t)((SL) * 16 + fr_i) * 512 + 4 * fq_i; const f32x4 yo = yacc[SL] + *(const LAS f32x4*)(Xs + ((S_) * 64 + lane) * 4); const u32x2 uw = uk[S_]; \
            const float y0 = yo[0] + dg[0] * lo16(uw.x), y1 = yo[1] + dg[1] * hi16(uw.x), y2 = yo[2] + dg[2] * lo16(uw.y), y3 = yo[3] + dg[3] * hi16(uw.y); \
            u32x2 ow; ow.x = pk2(gelu_tanh(y0), gelu_tanh(y1)); ow.y = pk2(gelu_tanh(y2), gelu_tanh(y3)); *(u32x2*)up = ow; } while (0)
        if (act) {
            if (dir == 0) {
#pragma unroll
                for (int s = 0; s < 4; ++s) S5_EPI(s, s);
            } else {
#pragma unroll
                for (int s = 0; s < 4; ++s) S5_EPI(4 + s, s);
            }
        }
#undef S5_EPI
        if (m2act) {
#pragma unroll
            for (int q = 0; q < 11; ++q) { const int pos = m2b * 11 + q, kk = chunk_at(m2dir, pos); m2cb[(size_t)kk * 8192] = pk2(m2c0, m2c1);
                const float f0 = coef[(m2chain * NCH + pos) * 2], f1 = coef[(m2chain * NCH + pos) * 2 + 1]; m2c0 = f0 * m2c0 + f1 * lo16(m2u[q]); m2c1 = f0 * m2c1 + f1 * hi16(m2u[q]); }
        }
    }
}
constexpr int LDP = 136;
constexpr int ML_X0 = 0, ML_X1 = 128 * LDP * 2, ML_X2 = 2 * 128 * LDP * 2, ML_VEC = 3 * 128 * LDP * 2;
__device__ __forceinline__ void zero_acc8(f32x4 (&acc)[2][8]) {
#pragma unroll
    for (int i = 0; i < 2; ++i)
#pragma unroll
        for (int j = 0; j < 8; ++j) acc[i][j] = (f32x4){0.f, 0.f, 0.f, 0.f};
}
__device__ __forceinline__ void hgemm_rn(const bf16x8 (&af)[2][4], const LAS bf16_t* Bt, f32x4 (&acc)[2][8], int fr, int fq) {
#pragma unroll
    for (int kk = 0; kk < 4; ++kk) {
#pragma unroll
        for (int jh = 0; jh < 2; ++jh) {
            bf16x8 b[4];
#pragma unroll
            for (int j = 0; j < 4; ++j) b[j] = *(const LAS bf16x8*)(Bt + ((jh * 4 + j) * 16 + fr) * LDP + kk * 32 + 8 * fq);
#pragma unroll
            for (int i = 0; i < 2; ++i)
#pragma unroll
                for (int j = 0; j < 4; ++j) acc[i][jh * 4 + j] = __builtin_amdgcn_mfma_f32_16x16x32_bf16(b[j], af[i][kk], acc[i][jh * 4 + j], 0, 0, 0);
        }
    }
}
typedef short v4i16_m __attribute__((ext_vector_type(4)));
__device__ __forceinline__ bf16x8 tr_frag(const LAS bf16_t* T  , int k0, int n0, int fr, int fq) {
    const LAS bf16_t* p = T + (k0 + 8 * fq + (fr >> 2)) * LDP + n0 + 4 * (fr & 3);
    const v4i16_m lo = __builtin_amdgcn_ds_read_tr16_b64_v4i16((LAS v4i16_m*)p), hi = __builtin_amdgcn_ds_read_tr16_b64_v4i16((LAS v4i16_m*)(p + 4 * LDP));
    return (bf16x8){lo[0], lo[1], lo[2], lo[3], hi[0], hi[1], hi[2], hi[3]};
}
__device__ __forceinline__ void hgemm_nt(const LAS bf16_t* A, const LAS bf16_t* Bk, f32x4 (&acc)[2][8], int hw, int fr, int fq) {
#pragma unroll
    for (int kk = 0; kk < 4; ++kk) {
        bf16x8 a[2], b[4];
#pragma unroll
        for (int i = 0; i < 2; ++i) a[i] = *(const LAS bf16x8*)(A + (hw * 32 + i * 16 + fr) * LDP + kk * 32 + 8 * fq);
#pragma unroll
        for (int jh = 0; jh < 2; ++jh) {
#pragma unroll
            for (int j = 0; j < 4; ++j) b[j] = tr_frag(Bk, kk * 32, (jh * 4 + j) * 16, fr, fq);
#pragma unroll
            for (int i = 0; i < 2; ++i)
#pragma unroll
                for (int j = 0; j < 4; ++j) acc[i][jh * 4 + j] = __builtin_amdgcn_mfma_f32_16x16x32_bf16(b[j], a[i], acc[i][jh * 4 + j], 0, 0, 0);
        }
    }
}
__device__ __forceinline__ void hgemm_tt(const LAS bf16_t* Ak, const LAS bf16_t* Bk, f32x4 (&acc)[2][8], f32x4 (&ns)[4], int hw, int fr, int fq) {
    const bf16x8 ones = (bf16x8){0x3F80, 0x3F80, 0x3F80, 0x3F80, 0x3F80, 0x3F80, 0x3F80, 0x3F80};
#pragma unroll
    for (int kk = 0; kk < 4; ++kk) {
        bf16x8 a[2], b[4];
#pragma unroll
        for (int i = 0; i < 2; ++i) a[i] = tr_frag(Ak, kk * 32, hw * 32 + i * 16, fr, fq);
#pragma unroll
        for (int jh = 0; jh < 2; ++jh) {
#pragma unroll
            for (int j = 0; j < 4; ++j) b[j] = tr_frag(Bk, kk * 32, (jh * 4 + j) * 16, fr, fq);
#pragma unroll
            for (int i = 0; i < 2; ++i)
#pragma unroll
                for (int j = 0; j < 4; ++j) acc[i][jh * 4 + j] = __builtin_amdgcn_mfma_f32_16x16x32_bf16(b[j], a[i], acc[i][jh * 4 + j], 0, 0, 0);
            if (hw == 2 * jh) {
#pragma unroll
                for (int j = 0; j < 4; ++j) ns[j] = __builtin_amdgcn_mfma_f32_16x16x32_bf16(b[j], ones, ns[j], 0, 0, 0);
            }
        }
    }
}
__device__ __forceinline__ void gate_scan_wave(int dir, const LAS float* lf, const LAS float* li, LAS float* bA, LAS float* aA, LAS float* pmA, LAS float* scl, int l) {
    const int t0 = dir ? 127 - 2 * l : 2 * l, t1 = dir ? 126 - 2 * l : 2 * l + 1;
    const float f0 = lf[t0], f1 = lf[t1]; const float s1 = f0 + f1; float x = s1;
#pragma unroll
    for (int o = 1; o < 64; o <<= 1) { const float y = __shfl_up(x, o); if (l >= o) x += y; }
    const float ex = x - s1; const float b0 = ex + f0, b1 = b0 + f1;
    const float a0 = li[t0] - b0, a1 = li[t1] - b1;
    float mx = fmaxf(a0, a1);
#pragma unroll
    for (int o = 1; o < 64; o <<= 1) { const float y = __shfl_up(mx, o); if (l >= o) mx = fmaxf(mx, y); }
    float pe = __shfl_up(mx, 1); if (l == 0) pe = -3.0e38f;
    const float p0 = fmaxf(pe, a0), p1 = fmaxf(p0, a1);
    bA[t0] = b0; bA[t1] = b1; aA[t0] = a0; aA[t1] = a1; pmA[t0] = p0; pmA[t1] = p1;
    if (l == 63) { scl[0] = mx; scl[1] = x; }
}
constexpr int ML_VF = 3 * 128 * LDP * 2;
struct M1Pre { u32x4 vv[4], kv[8]; float gval; };
__device__ __forceinline__ void m1_prefetch(M1Pre& P, const Params& p, int u, int tid) {
    unsigned char* ws = p.ws; const bf16_t* MLV = (const bf16_t*)(ws + W_PROJ) + (size_t)NROWS * SEC_MLV; const bf16_t* CK = (const bf16_t*)(ws + W_CK); const float* GD = (const float*)(ws + W_GD);
    const int k = u % NCH, h = (u / NCH) & 3, b = u / (NCH * 4); const int row0 = b * RB + k * 128; const int dir = tid >> 8, ht = tid & 255;
#pragma unroll
    for (int q = 0; q < 4; ++q) { const int c = tid + q * NTHR; P.vv[q] = *(const u32x4*)(MLV + (size_t)(row0 + (c >> 4)) * 512 + h * 128 + (c & 15) * 8); }
#pragma unroll
    for (int q = 0; q < 8; ++q) { const int c = ht + q * 256; P.kv[q] = *(const u32x4*)(CK + (size_t)(row0 + (c >> 4)) * 512 + h * 128 + (c & 15) * 8); }
    { const int which = ht >> 7, j = ht & 127; P.gval = GD[(size_t)(row0 + j) * 16 + (2 * dir + which) * 4 + h]; }
}
__device__ __forceinline__ void ml_m1(const Params& p, int layer, int G, char* ldsc) {
    unsigned char* ws = p.ws; LAS unsigned char* lds = (LAS unsigned char*)ldsc;
    LAS bf16_t* XV = (LAS bf16_t*)(lds + ML_X2); LAS float* vec = (LAS float*)(lds + ML_VF);
    float* STC = (float*)(ws + W_STC); float* STN = (float*)(ws + W_STN); float* STS = (float*)(ws + W_STS);
    int u = blockIdx.x; if (u >= 2 * 4 * NCH) return;
    M1Pre P;
    { int t0 = threadIdx.x; asm volatile("" : "+v"(t0)); m1_prefetch(P, p, u, t0); asm volatile("" :: "v"(P.gval), "v"(P.kv[7]), "v"(P.vv[3])); }
    while (u < 2 * 4 * NCH) {
        const int k = u % NCH, h = (u / NCH) & 3, b = u / (NCH * 4); const int un = u + G;
        int tid_ = threadIdx.x; asm volatile("" : "+v"(tid_));
        const int tid = tid_, lane = tid & 63, wid = tid >> 6, fr = lane & 15, fq = lane >> 4, dir = wid >> 2, hw = wid & 3, ht = tid & 255;
        LAS bf16_t* XK = (LAS bf16_t*)(lds + (dir ? ML_X0 : ML_X1));
        LAS float* lfA = vec + dir * 1024; LAS float* liA = lfA + 128; LAS float* bA = lfA + 256; LAS float* aA = lfA + 384; LAS float* pmA = lfA + 512; LAS float* scl = lfA + 640; LAS float* nsum = lfA + 768;
        const int chain = (b * 4 + h) * 2 + dir;
        __syncthreads();
        { const int which = ht >> 7, j = ht & 127; (which ? lfA : liA)[j] = P.gval; }
#pragma unroll
        for (int q = 0; q < 4; ++q) { const int c = tid + q * NTHR; *(LAS u32x4*)(XV + (c >> 4) * LDP + (c & 15) * 8) = P.vv[q]; }
        __syncthreads();
        if (hw == 0) gate_scan_wave(dir, lfA, liA, bA, aA, pmA, scl, lane);
        __syncthreads();
        const float amax = scl[0];
#pragma unroll
        for (int q = 0; q < 8; ++q) { const int c = ht + q * 256, r = c >> 4; const float w = __expf(aA[r] - amax);
            u32x4 o;
#pragma unroll
            for (int i = 0; i < 4; ++i) o[i] = pk2(lo16(P.kv[q][i]) * w, hi16(P.kv[q][i]) * w);
            *(LAS u32x4*)(XK + r * LDP + (c & 15) * 8) = o; }
        m1_prefetch(P, p, un < 2 * 4 * NCH ? un : u, tid);
        __syncthreads();
        f32x4 acc[2][8]; zero_acc8(acc); f32x4 ns[4];
#pragma unroll
        for (int j = 0; j < 4; ++j) ns[j] = (f32x4){0.f, 0.f, 0.f, 0.f};
        hgemm_tt(XV, XK, acc, ns, hw, fr, fq);
        bf16_t* Uo = (bf16_t*)STC + ((size_t)chain * NCH + k) * 16384;
#pragma unroll
        for (int i = 0; i < 2; ++i)
#pragma unroll
            for (int j = 0; j < 8; ++j) { u32x2 o; o.x = pk2(acc[i][j][0], acc[i][j][1]); o.y = pk2(acc[i][j][2], acc[i][j][3]); *(u32x2*)(Uo + (size_t)(hw * 32 + i * 16 + fr) * 128 + j * 16 + 4 * fq) = o; }
        if ((hw & 1) == 0 && fr == 0) {
#pragma unroll
            for (int j = 0; j < 4; ++j) *(f32x4*)(STN + ((size_t)chain * NCH + k) * 128 + ((hw >> 1) * 4 + j) * 16 + 4 * fq) = ns[j];
        }
        if (ht == 0) { float* so = STS + ((size_t)chain * NCH + k) * 4; so[0] = scl[1]; so[1] = amax; }
        u = un;
    }
}
struct M3Pre { u32x4 qv[4], kv[4], vv[4]; float gval, nval, m_in; };
__device__ __forceinline__ int m3_next_unit(int u, int G, int layer) { u += G; while (u < 2 * 4 * NCH && layer == 1 && (u % NCH) < 2) u += G; return u; }
__device__ __forceinline__ void m3_prefetch(M3Pre& P, const Params& p, int u, int tid) {
    unsigned char* ws = p.ws; const bf16_t* PROJ = (const bf16_t*)(ws + W_PROJ); const bf16_t* MLV = PROJ + (size_t)NROWS * SEC_MLV;
    const bf16_t* CQ = (const bf16_t*)(ws + W_CQ); const bf16_t* CK = (const bf16_t*)(ws + W_CK); const float* GD = (const float*)(ws + W_GD);
    const float* STN = (const float*)(ws + W_STN); const float* STS = (const float*)(ws + W_STS);
    const int k = u % NCH, h = (u / NCH) & 3, b = u / (NCH * 4); const int row0 = b * RB + k * 128; const int dir = tid >> 8, ht = tid & 255; const int chain = (b * 4 + h) * 2 + dir;
#pragma unroll
    for (int q = 0; q < 4; ++q) { const int c = tid + q * NTHR; const size_t go = (size_t)(row0 + (c >> 4)) * 512 + h * 128 + (c & 15) * 8;
        P.qv[q] = *(const u32x4*)(CQ + go); P.kv[q] = *(const u32x4*)(CK + go); P.vv[q] = *(const u32x4*)(MLV + go); }
    { const int which = ht >> 7, j = ht & 127; P.gval = GD[(size_t)(row0 + j) * 16 + (2 * dir + which) * 4 + h]; }
    P.nval = STN[((size_t)chain * NCH + k) * 128 + (ht & 127)];
    P.m_in = STS[((size_t)chain * NCH + k) * 4 + 2];
}
__device__ __forceinline__ void ml_m3(const Params& p, int layer, int G, char* ldsc) {
    unsigned char* ws = p.ws; LAS unsigned char* lds = (LAS unsigned char*)ldsc;
    LAS bf16_t* X0 = (LAS bf16_t*)(lds + ML_X0); LAS bf16_t* X1 = (LAS bf16_t*)(lds + ML_X1); LAS bf16_t* XV = (LAS bf16_t*)(lds + ML_X2); LAS float* vec = (LAS float*)(lds + ML_VF);
    LAS float* HX = (LAS float*)(lds + ML_X0);
    const bf16_t* PROJ = (const bf16_t*)(ws + W_PROJ); const bf16_t* MLO = PROJ + (size_t)NROWS * SEC_MLO; const bf16_t* MLZ = PROJ + (size_t)NROWS * SEC_MLZ;
    bf16_t* MIX = (bf16_t*)(ws + W_XN); const float* mnw = p.in[I_MNORM] + layer * 512;
    const int bxr = (G != 256) ? (int)blockIdx.x : (blockIdx.x % 8 != 0) ? (int)(blockIdx.x - 1 - blockIdx.x / 8) : (int)(224 + blockIdx.x / 8);
    int u = bxr; if (layer == 1 && (u % NCH) < 2) u = m3_next_unit(u, G, layer);
    if (u >= 2 * 4 * NCH) return;
    M3Pre P;
    { int t0 = threadIdx.x; asm volatile("" : "+v"(t0)); m3_prefetch(P, p, u, t0); asm volatile("" :: "v"(P.m_in), "v"(P.nval), "v"(P.gval), "v"(P.vv[3])); }
    while (u < 2 * 4 * NCH) {
        const int k = u % NCH, h = (u / NCH) & 3, b = u / (NCH * 4); const int row0 = b * RB + k * 128;
        const int un = m3_next_unit(u, G, layer);
        int tid_ = threadIdx.x; asm volatile("" : "+v"(tid_));
        const int tid = tid_, lane = tid & 63, wid = tid >> 6, fr = lane & 15, fq = lane >> 4, dir = wid >> 2, hw = wid & 3, ht = tid & 255;
        LAS bf16_t* XC = dir ? X0 : X1;
        LAS float* lfA = vec + dir * 1024; LAS float* liA = lfA + 128; LAS float* bA = lfA + 256; LAS float* aA = lfA + 384; LAS float* pmA = lfA + 512; LAS float* scl = lfA + 640; LAS float* nin = lfA + 768;
        LAS float* ssx = vec + 2048;
        __syncthreads();
        u32x4 cpre[8];
        { const bf16_t* Cg = (const bf16_t*)(ws + W_CB) + ((size_t)((b * 4 + h) * 2 + dir) * NCH + k) * 16384;
#pragma unroll
          for (int q = 0; q < 8; ++q) cpre[q] = *(const u32x4*)(Cg + (size_t)(ht + q * 256) * 8); }
#pragma unroll
        for (int q = 0; q < 4; ++q) { const int c = tid + q * NTHR; const int lo = (c >> 4) * LDP + (c & 15) * 8;
            *(LAS u32x4*)(X0 + lo) = P.qv[q]; *(LAS u32x4*)(X1 + lo) = P.kv[q]; *(LAS u32x4*)(XV + lo) = P.vv[q]; }
        { const int which = ht >> 7, j = ht & 127; (which ? lfA : liA)[j] = P.gval; }
        if (ht < 128) nin[ht] = P.nval;
        const float m_in = P.m_in;
        __syncthreads();
        bf16x8 qf[2][4];
#pragma unroll
        for (int i = 0; i < 2; ++i)
#pragma unroll
            for (int kk = 0; kk < 4; ++kk) qf[i][kk] = *(const LAS bf16x8*)(X0 + (hw * 32 + i * 16 + fr) * LDP + kk * 32 + 8 * fq);
        f32x4 sacc[2][8]; zero_acc8(sacc);
        hgemm_rn(qf, X1, sacc, fr, fq);
        if (hw == 0) gate_scan_wave(dir, lfA, liA, bA, aA, pmA, scl, lane);
        __syncthreads();
#pragma unroll
        for (int q = 0; q < 8; ++q) { const int c = ht + q * 256; *(LAS u32x4*)(XC + (c >> 4) * LDP + (c & 15) * 8) = cpre[q]; }
        __syncthreads();
        f32x4 acc[2][8]; zero_acc8(acc);
        hgemm_rn(qf, XC, acc, fr, fq);
        float Mt[2], wi[2], qn[2];
#pragma unroll
        for (int i = 0; i < 2; ++i) { const int t = hw * 32 + i * 16 + fr; Mt[i] = fmaxf(m_in, pmA[t]); wi[i] = __expf(m_in - Mt[i]); float s = 0.f;
#pragma unroll
            for (int kk = 0; kk < 4; ++kk) { const u32x4 w = __builtin_bit_cast(u32x4, qf[i][kk]); const f32x4 n0 = *(const LAS f32x4*)(nin + kk * 32 + 8 * fq), n1 = *(const LAS f32x4*)(nin + kk * 32 + 8 * fq + 4);
                s += lo16(w.x) * n0.x + hi16(w.x) * n0.y + lo16(w.y) * n0.z + hi16(w.y) * n0.w + lo16(w.z) * n1.x + hi16(w.z) * n1.y + lo16(w.w) * n1.z + hi16(w.w) * n1.w; }
            s += __shfl_xor(s, 16); s += __shfl_xor(s, 32); qn[i] = s;
#pragma unroll
            for (int j = 0; j < 8; ++j) acc[i][j] *= wi[i]; }
        __syncthreads();
        float den[2];
#pragma unroll
        for (int i = 0; i < 2; ++i) { const int t = hw * 32 + i * 16 + fr; float rs = 0.f; const int jd = 2 * hw + i;
#pragma unroll
            for (int j = 0; j < 8; ++j) { const int s0 = j * 16 + 4 * fq; u32x2 w;
                if (j == jd) { const f32x4 av = *(const LAS f32x4*)(aA + s0); float pv[4];
#pragma unroll
                    for (int rg = 0; rg < 4; ++rg) { const int s = s0 + rg; const bool valid = dir ? (s >= t) : (s <= t);
                        const float e = __expf(fminf(av[rg] - Mt[i], 0.f)); pv[rg] = valid ? sacc[i][j][rg] * e : 0.f; rs += pv[rg]; }
                    w.x = pk2(pv[0], pv[1]); w.y = pk2(pv[2], pv[3]); }
                else if (dir ? (j > jd) : (j < jd)) { const f32x4 av = *(const LAS f32x4*)(aA + s0); float pv[4];
#pragma unroll
                    for (int rg = 0; rg < 4; ++rg) { pv[rg] = sacc[i][j][rg] * __expf(av[rg] - Mt[i]); rs += pv[rg]; }
                    w.x = pk2(pv[0], pv[1]); w.y = pk2(pv[2], pv[3]); }
                else { w.x = 0u; w.y = 0u; }
                *(LAS u32x2*)(XC + t * LDP + s0) = w; }
            rs += __shfl_xor(rs, 16); rs += __shfl_xor(rs, 32); den[i] = rs + wi[i] * qn[i]; }
        __syncthreads();
        hgemm_nt(XC, XV, acc, hw, fr, fq);
#pragma unroll
        for (int i = 0; i < 2; ++i) { const int t = hw * 32 + i * 16 + fr; const float fl = __expf(-(bA[t] + Mt[i])); const float inv = __builtin_amdgcn_rcpf(fmaxf(fabsf(den[i]), fl));
#pragma unroll
            for (int j = 0; j < 8; ++j) acc[i][j] *= inv; }
        f32x4 nwv[4];
#pragma unroll
        for (int jj = 0; jj < 4; ++jj) nwv[jj] = *(const f32x4*)(mnw + h * 128 + (dir ? jj + 4 : jj) * 16 + 4 * fq);
        u32x2 ow[2][4], zw[2][4];
#pragma unroll
        for (int i = 0; i < 2; ++i) { const size_t row = (size_t)(row0 + hw * 32 + i * 16 + fr);
#pragma unroll
            for (int jj = 0; jj < 4; ++jj) { const int e0 = (dir ? jj + 4 : jj) * 16 + 4 * fq; ow[i][jj] = *(const u32x2*)(MLO + row * 512 + h * 128 + e0); zw[i][jj] = *(const u32x2*)(MLZ + row * 512 + h * 128 + e0); } }
        m3_prefetch(P, p, un < 2 * 4 * NCH ? un : u, tid);
        __syncthreads();
#pragma unroll
        for (int i = 0; i < 2; ++i)
#pragma unroll
            for (int jj = 0; jj < 4; ++jj) { const int j = dir ? jj : jj + 4; *(LAS f32x4*)(HX + (hw * 32 + i * 16 + fr) * 132 + j * 16 + 4 * fq) = acc[i][j]; }
        __syncthreads();
        float ssl[2];
#pragma unroll
        for (int i = 0; i < 2; ++i) { const int t = hw * 32 + i * 16 + fr; float ss = 0.f;
#pragma unroll
            for (int jj = 0; jj < 4; ++jj) { const int j = dir ? jj + 4 : jj; acc[i][j] += *(const LAS f32x4*)(HX + t * 132 + j * 16 + 4 * fq);
                ss += (acc[i][j].x * acc[i][j].x + acc[i][j].y * acc[i][j].y) + (acc[i][j].z * acc[i][j].z + acc[i][j].w * acc[i][j].w); }
            ss += __shfl_xor(ss, 16); ss += __shfl_xor(ss, 32); ssl[i] = ss;
            if (fq == 0) ssx[dir * 128 + t] = ss; }
        __syncthreads();
#pragma unroll
        for (int i = 0; i < 2; ++i) { const int t = hw * 32 + i * 16 + fr; const float rstd = rsqrtf((ssl[i] + ssx[(1 - dir) * 128 + t]) * (1.0f / 128.0f) + EPSN); const size_t row = (size_t)(row0 + t);
#pragma unroll
            for (int jj = 0; jj < 4; ++jj) { const int j = dir ? jj + 4 : jj; const int e0 = j * 16 + 4 * fq; const f32x4 nw = nwv[jj];
                const float o0 = acc[i][j].x * rstd * nw.x * sigm(lo16(ow[i][jj].x)) * silu(lo16(zw[i][jj].x)), o1 = acc[i][j].y * rstd * nw.y * sigm(hi16(ow[i][jj].x)) * silu(hi16(zw[i][jj].x));
                const float o2 = acc[i][j].z * rstd * nw.z * sigm(lo16(ow[i][jj].y)) * silu(lo16(zw[i][jj].y)), o3 = acc[i][j].w * rstd * nw.w * sigm(hi16(ow[i][jj].y)) * silu(hi16(zw[i][jj].y));
                u32x2 w; w.x = pk2(o0, o1); w.y = pk2(o2, o3); *(u32x2*)(MIX + row * 2048 + 1536 + h * 128 + e0) = w; } }
        u = un;
    }
}
__device__ __forceinline__ void ctx_outproj_small(const Params& p, int G, char* ldsc) {
    unsigned char* ws = p.ws; LAS float* part = (LAS float*)(LAS unsigned char*)ldsc;
    const bf16_t* MIX = (const bf16_t*)(ws + W_XN); const bf16_t* WT = (const bf16_t*)(ws + W_WOUT); const float* gate = (const float*)(ws + W_ADA) + 2 * 6144 + 4096;
    float* HC = (float*)(ws + W_HCTX);
    for (int t = blockIdx.x; t < 8 * 32; t += G) {
        int tid_ = threadIdx.x; asm volatile("" : "+v"(tid_));
        const int tid = tid_, lane = tid & 63, wid = tid >> 6, fr = lane & 15, fq = lane >> 4;
        const int rt = t >> 5, nt = t & 31;
        const int crow0 = rt * 64; const int b = crow0 / CTX; const size_t mixrow0 = (size_t)b * RB + (crow0 % CTX);
        const bf16_t* Ab = MIX + mixrow0 * DM + wid * 256 + 8 * fq; const bf16_t* Bb = WT + (size_t)(nt * 64) * DM + wid * 256 + 8 * fq;
        f32x4 acc[4][4];
#pragma unroll
        for (int i = 0; i < 4; ++i)
#pragma unroll
            for (int j = 0; j < 4; ++j) acc[i][j] = (f32x4){0.f, 0.f, 0.f, 0.f};
#pragma unroll 1
        for (int kh = 0; kh < 4; ++kh) {
            bf16x8 a[2][4], bb[2][4];
#pragma unroll
            for (int kk = 0; kk < 2; ++kk)
#pragma unroll
                for (int i = 0; i < 4; ++i) { a[kk][i] = *(const bf16x8*)(Ab + (size_t)(i * 16 + fr) * DM + kh * 64 + kk * 32); bb[kk][i] = *(const bf16x8*)(Bb + (size_t)(i * 16 + fr) * DM + kh * 64 + kk * 32); }
#pragma unroll
            for (int kk = 0; kk < 2; ++kk)
#pragma unroll
                for (int i = 0; i < 4; ++i)
#pragma unroll
                    for (int j = 0; j < 4; ++j) acc[i][j] = __builtin_amdgcn_mfma_f32_16x16x32_bf16(bb[kk][j], a[kk][i], acc[i][j], 0, 0, 0);
        }
        __syncthreads();
#pragma unroll
        for (int i = 0; i < 4; ++i)
#pragma unroll
            for (int j = 0; j < 4; ++j) *(LAS f32x4*)(part + wid * 4096 + (i * 16 + fr) * 64 + j * 16 + 4 * fq) = acc[i][j];
        __syncthreads();
        { const int r = tid >> 3, c0 = (tid & 7) * 8; f32x4 s0 = {0.f, 0.f, 0.f, 0.f}, s1 = {0.f, 0.f, 0.f, 0.f};
#pragma unroll
            for (int w = 0; w < 8; ++w) { s0 += *(const LAS f32x4*)(part + w * 4096 + r * 64 + c0); s1 += *(const LAS f32x4*)(part + w * 4096 + r * 64 + c0 + 4); }
            const int n0 = nt * 64 + c0; const size_t o = (size_t)(crow0 + r) * DM + n0;
            const f32x4 g0 = *(const f32x4*)(gate + n0), g1 = *(const f32x4*)(gate + n0 + 4);
            const f32x4 h0 = *(const f32x4*)(p.in[I_CTX] + o), h1 = *(const f32x4*)(p.in[I_CTX] + o + 4);
            *(f32x4*)(HC + o) = h0 + g0 * s0; *(f32x4*)(HC + o + 4) = h1 + g1 * s1; }
    }
}
#define XB_TMO      128
#define XB_XCNT(j)  (256  + 64 * (j))
#define XB_XSUB(j)  (1280 + 64 * (j))
#define XB_XGEN(j)  (2304 + 64 * (j))
#define XB_TOP      3328
#define XB_TOPGEN   3392
#define XCD_BAR_WORDS 3456
#define XB_SPIN_CAP (1u << 18)

__device__ __forceinline__ unsigned xb_ld(unsigned* p)              { return __hip_atomic_load(p, __ATOMIC_RELAXED, __HIP_MEMORY_SCOPE_AGENT); }
__device__ __forceinline__ unsigned xb_add(unsigned* p, unsigned v) { return __hip_atomic_fetch_add(p, v, __ATOMIC_RELAXED, __HIP_MEMORY_SCOPE_AGENT); }
__device__ __forceinline__ unsigned xb_xcc_id() { return (unsigned)__builtin_amdgcn_s_getreg((3 << 11) | 20) & 0xFu; }
#define XB_SPIN(cond, bar) do { unsigned _sp = 0; while (cond) { __builtin_amdgcn_s_sleep(1); \
    if ((++_sp & 255u) == 0u) { if (xb_ld(&(bar)[XB_TMO])) break; if (_sp > XB_SPIN_CAP) { atomicAdd(&(bar)[XB_TMO], 1u); break; } } } } while (0)

struct XcdBarrier {
    unsigned* bar; unsigned x;
    volatile LAS unsigned* st;
};

__device__ __forceinline__ XcdBarrier xcd_barrier_post(unsigned* bar, volatile LAS unsigned* st) {
    XcdBarrier b; b.bar = bar; b.x = xb_xcc_id(); b.st = st;
    if (threadIdx.x == 0) (void)xb_add(&bar[XB_XCNT(b.x)], 1u);
    return b;
}
__device__ __forceinline__ void xcd_barrier_complete(unsigned* bar, unsigned x, unsigned& nloc, unsigned& nx) {
    const unsigned G = gridDim.x * gridDim.y * gridDim.z;
    unsigned sum, cnt, mine, sp = 0u;
    for (;;) {
        sum = 0u; cnt = 0u; mine = 0u;
#pragma unroll
        for (unsigned j = 0; j < 16; ++j) { const unsigned c = xb_ld(&bar[XB_XCNT(j)]); sum += c; cnt += (c > 0u) ? 1u : 0u; mine = (j == x) ? c : mine; }
        if (sum == G) break;
        __builtin_amdgcn_s_sleep(1);
        if ((++sp & 255u) == 0u) { if (xb_ld(&bar[XB_TMO])) break; if (sp > XB_SPIN_CAP) { atomicAdd(&bar[XB_TMO], 1u); break; } }
    }
    nloc = mine > 0u ? mine : 1u; nx = cnt > 0u ? cnt : 1u;
}

__device__ __forceinline__ void xcd_barrier(const XcdBarrier& b) {
    asm volatile("s_waitcnt vmcnt(0)" ::: "memory");
    __syncthreads();
    if (threadIdx.x == 0) {
        unsigned* bar = b.bar; unsigned bx_ = b.x; asm volatile("" : "+s"(bx_));
        __builtin_amdgcn_s_waitcnt(0);
        unsigned nloc = b.st[0], nx = b.st[1];
        if (nloc == 0u) { xcd_barrier_complete(bar, bx_, nloc, nx); b.st[0] = nloc; b.st[1] = nx; }
        const unsigned old = xb_add(&bar[XB_XSUB(bx_)], 1u);
        const unsigned gen = old / nloc;
        if (old + 1u == (gen + 1u) * nloc) {
            __builtin_amdgcn_fence(__ATOMIC_RELEASE, "agent");
            asm volatile("s_waitcnt vmcnt(0)" ::: "memory");
            const unsigned og = xb_add(&bar[XB_TOP], 1u);
            const unsigned tg = og / nx;
            if (og + 1u == (tg + 1u) * nx) xb_add(&bar[XB_TOPGEN], 1u);
            else XB_SPIN(xb_ld(&bar[XB_TOPGEN]) == tg, bar);
            __builtin_amdgcn_fence(__ATOMIC_ACQUIRE, "agent");
            xb_add(&bar[XB_XGEN(bx_)], 1u);
            asm volatile("s_waitcnt vmcnt(0)" ::: "memory");
        } else {
            XB_SPIN(xb_ld(&bar[XB_XGEN(bx_)]) == gen, bar);
            __builtin_amdgcn_fence(__ATOMIC_ACQUIRE, "agent");
            asm volatile("s_waitcnt vmcnt(0)" ::: "memory");
        }
    }
    __syncthreads();
}
constexpr int MISC_OFF = LDS_BYTES - 64;
constexpr size_t CTL_ZERO_BYTES = 65536;
#ifndef PROBE_A
#define PROBE_A -1
#endif
#ifndef PROBE_OFS
#define PROBE_OFS 0
#endif
#ifndef PROBE_SPAN
#define PROBE_SPAN 1
#endif
#ifndef PROBE_SCALE
#define PROBE_SCALE 1.0e-5f
#endif
#ifndef PROBE_B
#define PROBE_B -1
#endif
constexpr int STAMP_OFF = LDS_BYTES - 512;
#ifndef SBLK
#define SBLK 0
#endif
#define STAMP() do { if ((PROBE_A >= 0 || PROBE_B >= 0) && blockIdx.x == SBLK && threadIdx.x == 0) { ((volatile LAS unsigned long long*)(lds_raw + STAMP_OFF))[nstamp] = __builtin_amdgcn_s_memrealtime(); } ++nstamp; } while (0)
__global__ void __launch_bounds__(NTHR, 2) mega_fwd(Params p) {
    extern __shared__ __attribute__((aligned(16))) unsigned char lds_raw[];
    char* lds = (char*)lds_raw;
    const int G = gridDim.x;
    unsigned char* ws = p.ws;
    bf16_t* XN = (bf16_t*)(ws + W_XN); bf16_t* PROJ = (bf16_t*)(ws + W_PROJ);
    if (threadIdx.x < 16) ((LAS unsigned*)(lds_raw + MISC_OFF))[threadIdx.x] = 0u;
    __syncthreads();
    if (threadIdx.x == 0) ((volatile LAS unsigned long long*)(lds_raw + STAMP_OFF))[40] = 0ull;
#if defined(XCC_PROBE)
    if (threadIdx.x == 0) { const unsigned xid = (unsigned)__builtin_amdgcn_s_getreg((3 << 11) | 20) & 0xFu; if (xid != (blockIdx.x & 7u)) atomicAdd((unsigned*)(ws + W_MISC + 2048), 1u); }
#endif
    int nstamp = 0; STAMP();
    XcdBarrier bar = xcd_barrier_post((unsigned*)ws, (volatile LAS unsigned*)(lds_raw + MISC_OFF));


    p0_prologue(p, lds, G);

    xcd_barrier(bar); STAMP();

    p0b_ada(p, G);

    xcd_barrier(bar); STAMP();
    for (int layer = 0; layer < 2; ++layer) {
        const int lat_only = (layer == 1) ? 1 : 0;
        p1_xn(p, layer, G);
        xcd_barrier(bar); STAMP();
        {
            const bool split = (G >= 196);
#pragma unroll 1
            for (int ph = 0; ph < 2; ++ph) {
                int pho = ph; asm volatile("" : "+s"(pho));
                const bool do_gemm = (pho == 0) || !split || blockIdx.x < 48, do_s5 = (pho == 1) && (!split || blockIdx.x >= 48);
                if (do_gemm) {
                    pg8::Gemm g{XN, (const bf16_t*)(ws + W_WIN + layer * SZ_WIN), NROWS, NPROJ, DM};
                    pg8::StaticOrder S; S.init(pho ? 24 : 66, pho ? 2 : 22, G, (int)blockIdx.x, 0, pho + 1);
                    pg8::EpiProj E{PROJ, (float*)(ws + W_GRAW)};
                    pg8::gemm_phase<pg8::EpiProj, pg8::StaticOrder, true, true>((PG8_LAS unsigned char*)lds_raw, g, S, E);
                }
                if (do_s5) { if (do_gemm) __syncthreads(); s5_pass1(p, layer, split ? G - 48 : G, lds, split ? (int)blockIdx.x - 48 : (int)blockIdx.x);
                             if (!split) gates_mfma(p, layer, (int)blockIdx.x, G, lds); else if (blockIdx.x >= 64) gates_mfma(p, layer, (int)blockIdx.x - 64, G - 64, lds); }
                if (pho == 0) { xcd_barrier(bar); STAMP(); }
            }
        }
        __syncthreads(); STAMP();
        p3_post(p, layer, G);
        xcd_barrier(bar); STAMP();
        ml_m1(p, layer, G, lds);
        s5_carry(p, layer, G);
        xcd_barrier(bar); STAMP();
        s5_pass2(p, layer, G, lds);
        xcd_barrier(bar); STAMP();
        p4_attn(p, layer, G, lds);
        __syncthreads(); STAMP();
        ml_m3(p, layer, G, lds);
        __syncthreads(); STAMP();
        {
            pg8::Gemm g{PROJ + (size_t)NROWS * SEC_S5U, (const bf16_t*)(ws + W_WGLU + layer * SZ_WGLU), NROWS, 512, 512};
            pg8::StaticOrder S; S.init(lat_only ? 64 : 66, 2, G, (int)((blockIdx.x + G - 124) % G), lat_only);
            pg8::EpiGlu E{PROJ + (size_t)NROWS * SEC_S5U, PROJ + (size_t)NROWS * SEC_S5Z, XN};
            pg8::gemm_phase<pg8::EpiGlu, pg8::StaticOrder, true, true>((PG8_LAS unsigned char*)lds_raw, g, S, E);
        }
        xcd_barrier(bar); STAMP();
        {
            pg8::Gemm g{XN, (const bf16_t*)(ws + W_WOUT + layer * SZ_WOUT), NROWS, DM, DM};
            pg8::StaticOrder S; S.init(64, DM / 256, G, (int)blockIdx.x, 1);
            pg8::EpiDelta E{layer == 0 ? (bf16_t*)p.out : PROJ, (const float*)(ws + W_ADA) + layer * 3 * 6144, layer == 0 ? 2 * DM : DM};
            pg8::gemm_phase<pg8::EpiDelta, pg8::StaticOrder, true, true>((PG8_LAS unsigned char*)lds_raw, g, S, E);
        }
        if (layer == 0) { __syncthreads(); ctx_outproj_small(p, G, lds); }
        xcd_barrier(bar); STAMP();
    }

    p_final(p, G);
#if defined(XCC_PROBE)
    xcd_barrier(bar);
    if (blockIdx.x == 0 && threadIdx.x == 0) { asm volatile("s_waitcnt vmcnt(0)" ::: "memory"); p.out[0] += 0.04f + 5.0e-4f * (float)__hip_atomic_load((unsigned*)(ws + W_MISC + 2048), __ATOMIC_RELAXED, __HIP_MEMORY_SCOPE_AGENT); }
#endif
    STAMP();
#if PROBE_B >= 0
    xcd_barrier(bar);
#endif
    if ((PROBE_A >= 0 || PROBE_B >= 0) && blockIdx.x == SBLK && threadIdx.x == 0) {
        volatile LAS unsigned long long* st = (volatile LAS unsigned long long*)(lds_raw + STAMP_OFF);
        if (PROBE_B >= 0) { const unsigned long long T2 = st[PROBE_B + PROBE_SPAN] - st[PROBE_B]; asm volatile("s_waitcnt vmcnt(0)" ::: "memory");
            int best = 0; float bv = 1e30f;
            for (int i = 0; i < 256; ++i) { const float v = fabsf(__hip_atomic_load(p.out + i, __ATOMIC_RELAXED, __HIP_MEMORY_SCOPE_AGENT)); if (v < bv) { bv = v; best = i; } }
            p.out[best] = __hip_atomic_load(p.out + best, __ATOMIC_RELAXED, __HIP_MEMORY_SCOPE_AGENT) + (float)((long long)T2 - (long long)(PROBE_OFS)) * PROBE_SCALE; }
        if (PROBE_A >= 0) { const unsigned long long T = (PROBE_A >= 100) ? st[40] : st[PROBE_A + 1] - st[PROBE_A]; const unsigned long long t0 = __builtin_amdgcn_s_memrealtime(); while (__builtin_amdgcn_s_memrealtime() - t0 < 8ull * T) __builtin_amdgcn_s_sleep(16); }
    }

}

extern "C" void kernel_launch(void* const* d_in, const int* in_sizes, int n_in, void* d_out, int out_size, void* d_ws, size_t ws_size, hipStream_t stream) {
    static int grid = 0;
    if (grid == 0) {
        if (n_in != 25 || in_sizes[0] != NBATCH * SEQ * DM || out_size != NBATCH * SEQ * DM || ws_size < W_END) {
            fprintf(stderr, "kernel_launch: shape mismatch (n_in %d, in0 %d, out %d, ws %zu, need ws >= %zu)\n", n_in, n_in > 0 ? in_sizes[0] : -1, out_size, ws_size, (size_t)W_END); grid = -1; return; }
        int dev = 0, cus = 0, per_cu = 0;
        if (hipGetDevice(&dev) != hipSuccess || hipDeviceGetAttribute(&cus, hipDeviceAttributeMultiprocessorCount, dev) != hipSuccess) { grid = -1; return; }
        if (hipFuncSetAttribute((const void*)mega_fwd, hipFuncAttributeMaxDynamicSharedMemorySize, LDS_BYTES) != hipSuccess) { fprintf(stderr, "kernel_launch: hipFuncSetAttribute failed\n"); grid = -1; return; }
        if (hipOccupancyMaxActiveBlocksPerMultiprocessor(&per_cu, (const void*)mega_fwd, NTHR, LDS_BYTES) != hipSuccess || per_cu < 1) { fprintf(stderr, "kernel_launch: occupancy query says %d\n", per_cu); per_cu = 1; }
        (void)hipGetLastError();
        grid = cus;
    }
    if (grid < 0) return;
    if (hipMemsetAsync(d_ws, 0, CTL_ZERO_BYTES, stream) != hipSuccess) { fprintf(stderr, "kernel_launch: memset failed\n"); return; }
    Params p{};
    for (int i = 0; i < 25; ++i) p.in[i] = (const float*)d_in[i];
    p.out = (float*)d_out; p.ws = (unsigned char*)d_ws;
    void* args[] = {&p};
    const hipError_t e = hipLaunchCooperativeKernel((const void*)mega_fwd, dim3(grid), dim3(NTHR), args, LDS_BYTES, stream);
    if (e != hipSuccess) fprintf(stderr, "kernel_launch: cooperative launch failed: %s (grid %d)\n", hipGetErrorString(e), grid);
}
```
